# Optimizing an MI355X kernel written in HIP

```python
import jax, jax.numpy as jnp
from jax import lax
import numpy as np

D_MODEL = 2048
BATCH = 2
SEQ = 4096
DEPTH = 1

SG_GROUPS = 8
SG_GROUP_DIM = 128
SG_WIDTH = SG_GROUPS * SG_GROUP_DIM
SG_CHUNK = 128
N_HEADS = 8
N_KV_HEADS = 2
HEAD_DIM = 128
Q_PER_KV = N_HEADS // N_KV_HEADS
Q_WIDTH = N_HEADS * HEAD_DIM
KV_WIDTH = N_KV_HEADS * HEAD_DIM
WINDOW = 128
BLOCK = 128
ROPE_THETA = 500000.0
ROT_DIM = HEAD_DIM // 4
N_BRANCHES = 2
D_FF = 5632
CONV_WIDTH = 3
EPS = 1e-6
MASK_VALUE = -1e30

IN_WIDTH = 2 * SG_WIDTH + Q_WIDTH + 2 * KV_WIDTH + N_BRANCHES * D_MODEL

kernel_name = "hybrid_sgmlp_swa_sink_convffn_block"


def rms_norm(x, g):
    xf = x.astype(jnp.float32)
    y = xf * lax.rsqrt(jnp.mean(xf * xf, axis=-1, keepdims=True) + EPS)
    return (y * g.astype(jnp.float32)).astype(x.dtype)


def layer_norm(x, g, b):
    xf = x.astype(jnp.float32)
    mu = jnp.mean(xf, axis=-1, keepdims=True)
    xc = xf - mu
    y = xc * lax.rsqrt(jnp.mean(xc * xc, axis=-1, keepdims=True) + EPS)
    return (y * g.astype(jnp.float32) + b.astype(jnp.float32)).astype(x.dtype)


def partial_rope(x):
    s = x.shape[1]
    pos = jnp.arange(s, dtype=jnp.float32)
    inv_freq = ROPE_THETA ** (-jnp.arange(0, ROT_DIM, 2, dtype=jnp.float32) / ROT_DIM)
    ang = pos[:, None] * inv_freq[None, :]
    cos = jnp.cos(ang)[None, :, None, :]
    sin = jnp.sin(ang)[None, :, None, :]
    xf = x.astype(jnp.float32)
    x1 = xf[..., : ROT_DIM // 2]
    x2 = xf[..., ROT_DIM // 2: ROT_DIM]
    rot = jnp.concatenate([x1 * cos - x2 * sin, x2 * cos + x1 * sin, xf[..., ROT_DIM:]], axis=-1)
    return rot.astype(x.dtype)


def spatial_gating(u, v, ln_g, ln_b, w_s, b_s):
    b, s, _ = v.shape
    nc = s // SG_CHUNK
    vn = layer_norm(v, ln_g, ln_b).reshape(b, nc, SG_CHUNK, SG_GROUPS, SG_GROUP_DIM)
    vz = jnp.einsum('gts,bcsgd->bctgd', w_s, vn) + b_s.T[None, None, :, :, None]
    return u * vz.reshape(b, s, SG_WIDTH)


def banded_blocks(t):
    b, s, kvh, d = t.shape
    nb = s // BLOCK
    tp = jnp.pad(t, ((0, 0), (BLOCK, BLOCK), (0, 0), (0, 0))).reshape(b, nb + 2, BLOCK, kvh, d)
    return jnp.concatenate([tp[:, :-2], tp[:, 1:-1], tp[:, 2:]], axis=2)


def windowed_gqa_sink(q, k, v, sink):
    b, s, _, _ = q.shape
    nb = s // BLOCK
    qb = q.reshape(b, nb, BLOCK, N_KV_HEADS, Q_PER_KV, HEAD_DIM)
    kb = banded_blocks(k)
    vb = banded_blocks(v)
    scores = jnp.einsum('bnqkgd,bnskd->bkgnqs', qb, kb).astype(jnp.float32) * (HEAD_DIM ** -0.5)
    blk = jnp.arange(nb)[:, None, None]
    q_pos = blk * BLOCK + jnp.arange(BLOCK)[None, :, None]
    k_pos = blk * BLOCK - BLOCK + jnp.arange(3 * BLOCK)[None, None, :]
    valid = (jnp.abs(k_pos - q_pos) <= WINDOW) & (k_pos >= 0) & (k_pos < s)
    scores = jnp.where(valid, scores, MASK_VALUE)
    sink_l = jnp.broadcast_to(
        sink.astype(jnp.float32).reshape(N_KV_HEADS, Q_PER_KV)[None, :, :, None, None, None],
        scores.shape[:-1] + (1,))
    probs = jax.nn.softmax(jnp.concatenate([scores, sink_l], axis=-1), axis=-1)[..., :-1]
    out = jnp.einsum('bkgnqs,bnskd->bnqkgd', probs.astype(v.dtype), vb)
    return out.reshape(b, s, Q_WIDTH)


def conv_glu_ffn(h, w_up, conv_w, conv_b, w_down):
    s = h.shape[1]
    up = h @ w_up
    pad = CONV_WIDTH // 2
    up_p = jnp.pad(up, ((0, 0), (pad, pad), (0, 0)))
    conv = conv_b + sum(conv_w[j] * up_p[:, j:j + s] for j in range(CONV_WIDTH))
    gate, val = jnp.split(conv, 2, axis=-1)
    return (jax.nn.gelu(gate, approximate=True) * val) @ w_down


def setup_inputs(seed: int = 0) -> dict:
    key = jax.random.key(seed)
    ks = jax.random.split(key, 20)
    f32 = jnp.float32

    def nrm(k, shape, scale):
        return jax.random.normal(k, shape, f32) * scale

    def gain(k, n):
        return 1.0 + 0.05 * jax.random.normal(k, (DEPTH, n), f32)

    return {
        "x": nrm(ks[0], (BATCH, SEQ, D_MODEL), 1.0),
        "norm_mix_pre": gain(ks[1], D_MODEL),
        "w_in": nrm(ks[2], (DEPTH, D_MODEL, IN_WIDTH), D_MODEL ** -0.5),
        "sg_ln_g": gain(ks[3], SG_WIDTH),
        "sg_ln_b": nrm(ks[4], (DEPTH, SG_WIDTH), 0.02),
        "sg_w": nrm(ks[5], (DEPTH, SG_GROUPS, SG_CHUNK, SG_CHUNK), SG_CHUNK ** -0.5),
        "sg_b": 1.0 + nrm(ks[6], (DEPTH, SG_GROUPS, SG_CHUNK), 0.05),
        "attn_sink": nrm(ks[7], (DEPTH, N_HEADS), 1.0),
        "w_branch_a": nrm(ks[8], (DEPTH, SG_WIDTH, D_MODEL), SG_WIDTH ** -0.5),
        "w_branch_b": nrm(ks[9], (DEPTH, Q_WIDTH, D_MODEL), Q_WIDTH ** -0.5),
        "w_out": nrm(ks[10], (DEPTH, D_MODEL, D_MODEL), D_MODEL ** -0.5),
        "norm_mix_post": gain(ks[11], D_MODEL),
        "norm_ffn_pre": gain(ks[12], D_MODEL),
        "w_up": nrm(ks[13], (DEPTH, D_MODEL, 2 * D_FF), D_MODEL ** -0.5),
        "conv_w": nrm(ks[14], (DEPTH, CONV_WIDTH, 2 * D_FF), CONV_WIDTH ** -0.5),
        "conv_b": nrm(ks[15], (DEPTH, 2 * D_FF), 0.01),
        "w_down": nrm(ks[16], (DEPTH, D_FF, D_MODEL), D_FF ** -0.5),
        "norm_ffn_post": gain(ks[17], D_MODEL),
    }


def reference(x, norm_mix_pre, w_in, sg_ln_g, sg_ln_b, sg_w, sg_b, attn_sink,
              w_branch_a, w_branch_b, w_out, norm_mix_post, norm_ffn_pre,
              w_up, conv_w, conv_b, w_down, norm_ffn_post):
    b, s, _ = x.shape
    split_at = np.cumsum([SG_WIDTH, SG_WIDTH, Q_WIDTH, KV_WIDTH, KV_WIDTH]).tolist()
    for l in range(DEPTH):
        h = rms_norm(x, norm_mix_pre[l])
        z = h @ w_in[l]
        u, v, q, k, vv, g = jnp.split(z, split_at, axis=-1)
        a_out = spatial_gating(jax.nn.gelu(u, approximate=True), jax.nn.gelu(v, approximate=True),
                               sg_ln_g[l], sg_ln_b[l], sg_w[l], sg_b[l])
        q = partial_rope(q.reshape(b, s, N_HEADS, HEAD_DIM))
        k = partial_rope(k.reshape(b, s, N_KV_HEADS, HEAD_DIM))
        vv = vv.reshape(b, s, N_KV_HEADS, HEAD_DIM)
        b_out = windowed_gqa_sink(q, k, vv, attn_sink[l])
        gates = jax.nn.sigmoid(g.reshape(b, s, N_BRANCHES, D_MODEL))
        merged = gates[:, :, 0] * (a_out @ w_branch_a[l]) + gates[:, :, 1] * (b_out @ w_branch_b[l])
        x = x + rms_norm(merged @ w_out[l], norm_mix_post[l])
        hf = rms_norm(x, norm_ffn_pre[l])
        f = conv_glu_ffn(hf, w_up[l], conv_w[l], conv_b[l], w_down[l])
        x = x + rms_norm(f, norm_ffn_post[l])
    return x
```

```cpp
#include <hip/hip_runtime.h>
#include <cstdio>
#include <cstdint>
namespace pg8 {
#define PG8_LAS __attribute__((address_space(3)))
typedef unsigned short bf16_t;
typedef short bf16x8 __attribute__((ext_vector_type(8)));
typedef float f32x4 __attribute__((ext_vector_type(4)));
typedef unsigned u32x4 __attribute__((ext_vector_type(4)));
constexpr int BM = 256, BK = 64, HALF = 128, HTB = HALF * BK * 2  , STAGE_BYTES = 8 * HTB, NXCD = 8, WGM = 8;

__host__ __device__ __forceinline__ int lds_byte(int r, int c) { const int st = (r >> 4) * 2 + (c >> 5), rr = r & 15, cc = c & 31, ob = rr * 64 + cc * 2; return st * 1024 + (ob ^ (((ob >> 9) & 1) << 5)); }
__host__ __device__ __forceinline__ void stage_rc(int b, int& R, int& C) { const int st = b / 1024, sb = b % 1024, swz = sb ^ (((sb >> 9) & 1) << 5); R = (st >> 1) * 16 + swz / 64; C = (st & 1) * 32 + (swz % 64) / 2; }
__host__ __device__ __forceinline__ int perm32(int rho) { const int n = rho >> 4, i = rho & 15; return 8 * (i >> 2) + 4 * n + (i & 3); }

struct Unit { int pm, pn; };
struct Gemm { const bf16_t* A; const bf16_t* Bt; int M, N, K, lda, ldb, pad; };

struct StaticOrder {
    int nM, nN, nwg, G, c;
    __host__ __device__ void init(int M, int N, int G_, int c_) { nM = M / BM; nN = N / BM; nwg = nM * nN; G = G_; c = c_; }
    __host__ __device__ bool next(int i, Unit& u) const {
        const long L = (long)i * G + c; if (L >= nwg) return false;
        int wgid = (int)L; { const int q = nwg / NXCD, r = nwg % NXCD, xcd = wgid % NXCD, off = wgid / NXCD; wgid = (xcd < r ? xcd * (q + 1) : r * (q + 1) + (xcd - r) * q) + off; }
        const int nig = WGM * nN, gid = wgid / nig, fm = gid * WGM, gsz = (nM - fm) < WGM ? (nM - fm) : WGM;
        u.pm = fm + ((wgid % nig) % gsz); u.pn = (wgid % nig) / gsz; return true;
    }
    __device__ __forceinline__ void a_ready(const Unit&) const {}
    __device__ __forceinline__ void done(const Unit&) const {}
};


__device__ __forceinline__ unsigned cvt_pk_bf16(float lo, float hi) { unsigned r; asm volatile("v_cvt_pk_bf16_f32 %0, %1, %2" : "=v"(r) : "v"(lo), "v"(hi)); return r; }
typedef unsigned u32x2 __attribute__((ext_vector_type(2)));

struct EpiBf16Plain {
    static constexpr bool PERM = true, AFTER_DRAIN = false;
    bf16_t* O; int ldc, pad;
    __device__ __forceinline__ void operator()(const f32x4 (&acc)[2][2][4][2], const Unit& u, int wr, int wc, int fr, int fq) const {
        const int row0 = u.pm * BM + wr * 64 + fr, col0 = u.pn * BM + wc * 32 + 8 * fq;
#pragma unroll
        for (int ai = 0; ai < 2; ++ai)
#pragma unroll
            for (int m = 0; m < 4; ++m) { bf16_t* rowp = O + (size_t)(row0 + ai * HALF + m * 16) * ldc + col0;
#pragma unroll
                for (int bj = 0; bj < 2; ++bj) { const f32x4 v0 = acc[ai][bj][m][0], v1 = acc[ai][bj][m][1];
                    u32x4 w; w.x = cvt_pk_bf16(v0[0], v0[1]); w.y = cvt_pk_bf16(v0[2], v0[3]); w.z = cvt_pk_bf16(v1[0], v1[1]); w.w = cvt_pk_bf16(v1[2], v1[3]);
                    *(u32x4*)(rowp + bj * HALF) = w; } }
    }
};
__device__ __forceinline__ float bfbits2f(unsigned short v) { return __uint_as_float(((unsigned)v) << 16); }
struct EpiF32 {
    static constexpr bool PERM = false, AFTER_DRAIN = false;
    float* O; const bf16_t* S; int ldc, lds_;
    __device__ __forceinline__ void operator()(const f32x4 (&acc)[2][2][4][2], const Unit& u, int wr, int wc, int fr, int fq) const {
        const int row0 = u.pm * BM + wr * 64 + fr, col0 = u.pn * BM + wc * 32 + 4 * fq;
#pragma unroll
        for (int ai = 0; ai < 2; ++ai)
#pragma unroll
            for (int m = 0; m < 4; ++m) { const size_t r = (size_t)(row0 + ai * HALF + m * 16);
#pragma unroll
                for (int bj = 0; bj < 2; ++bj)
#pragma unroll
                    for (int n = 0; n < 2; ++n) { f32x4 v = acc[ai][bj][m][n]; const int c = col0 + bj * HALF + n * 16;
                        if (S) { const u32x2 s = *(const u32x2*)(S + r * lds_ + c);
                            v[0] *= __uint_as_float(s.x << 16); v[1] *= __uint_as_float(s.x & 0xffff0000u); v[2] *= __uint_as_float(s.y << 16); v[3] *= __uint_as_float(s.y & 0xffff0000u); }
                        *(f32x4*)(O + r * ldc + c) = v; } }
    }
};
struct EpiMerge {
    static constexpr bool PERM = false, AFTER_DRAIN = false;
    bf16_t* O; const float* P; const bf16_t* S; int ldc, pad;
    __device__ __forceinline__ void operator()(const f32x4 (&acc)[2][2][4][2], const Unit& u, int wr, int wc, int fr, int fq) const {
        const int row0 = u.pm * BM + wr * 64 + fr, col0 = u.pn * BM + wc * 32 + 4 * fq;
#pragma unroll
        for (int ai = 0; ai < 2; ++ai)
#pragma unroll
            for (int m = 0; m < 4; ++m) { const size_t r = (size_t)(row0 + ai * HALF + m * 16);
#pragma unroll
                for (int bj = 0; bj < 2; ++bj)
#pragma unroll
                    for (int n = 0; n < 2; ++n) { const int c = col0 + bj * HALF + n * 16; f32x4 v = acc[ai][bj][m][n] + *(const f32x4*)(P + r * ldc + c);
                        const u32x2 s = *(const u32x2*)(S + r * ldc + c);
                        v[0] *= __uint_as_float(s.x << 16); v[1] *= __uint_as_float(s.x & 0xffff0000u); v[2] *= __uint_as_float(s.y << 16); v[3] *= __uint_as_float(s.y & 0xffff0000u);
                        u32x2 w; w.x = cvt_pk_bf16(v[0], v[1]); w.y = cvt_pk_bf16(v[2], v[3]); *(u32x2*)(O + r * ldc + c) = w; } }
    }
};

template <class Epi, class Sched, bool ALIGN_EPI = false, bool SP2 = false>
__device__ __forceinline__ void gemm_phase(PG8_LAS unsigned char* lds, const Gemm g, const Sched& S, const Epi& E) {
    const int tid = threadIdx.x, wid = __builtin_amdgcn_readfirstlane(tid >> 6), lane = tid & 63, wr = wid >> 2, wc = wid & 3, fr = lane & 15, fq = lane >> 4;
    const int K = g.K, nt = K / BK;
    unsigned voffA[2], voffB[2];
#pragma unroll
    for (int i = 0; i < 2; ++i) { int R, C; stage_rc(tid * 16 + i * 8192, R, C); const int Rb = Epi::PERM ? ((R & ~31) + perm32(R & 31)) : R;
        voffA[i] = (unsigned)(R * g.lda + C) * 2u; voffB[i] = (unsigned)(Rb * g.ldb + C) * 2u; }
    const size_t kstep = (size_t)(BK * 2);
    const size_t hstepA = (size_t)HALF * g.lda * 2, hstepB = (size_t)HALF * g.ldb * 2;
    const size_t tstepA = 2 * hstepA, tstepB = 2 * hstepB;
    const unsigned ldsw = (unsigned)wid * 1024u;
    const int aoff = lds_byte(wr * 64 + fr, fq * 8), boff = lds_byte(wc * 32 + fr, fq * 8);
#define PG8_SA(b, h) (((b) * 2 + (h)) * HTB)
#define PG8_SB(b, h) ((4 + (b) * 2 + (h)) * HTB)
#define PG8_STAGE(bufoff, gbase, voff) do { _Pragma("unroll") for (int _i = 0; _i < 2; ++_i) \
        __builtin_amdgcn_global_load_lds((const unsigned*)((const char*)(gbase) + (voff)[_i]), (PG8_LAS unsigned*)(lds + (bufoff) + ldsw + _i * 8192), 16, 0, 0); } while (0)
#define PG8_LDA(dst, b, h) do { _Pragma("unroll") for (int m = 0; m < 4; ++m) _Pragma("unroll") for (int k = 0; k < 2; ++k) dst[m][k] = *(const PG8_LAS bf16x8*)(lds + PG8_SA(b, h) + aoff + m * 2048 + k * 1024); } while (0)
#define PG8_LDB(dst, b, h) do { _Pragma("unroll") for (int n = 0; n < 2; ++n) _Pragma("unroll") for (int k = 0; k < 2; ++k) dst[n][k] = *(const PG8_LAS bf16x8*)(lds + PG8_SB(b, h) + boff + n * 2048 + k * 1024); } while (0)
#define PG8_MMA(ai, bj, At, Bt) do { __builtin_amdgcn_s_setprio(1); _Pragma("unroll") for (int m = 0; m < 4; ++m) _Pragma("unroll") for (int n = 0; n < 2; ++n) _Pragma("unroll") for (int k = 0; k < 2; ++k) \
        acc[ai][bj][m][n] = __builtin_amdgcn_mfma_f32_16x16x32_bf16(Bt[n][k], At[m][k], acc[ai][bj][m][n], 0, 0, 0); __builtin_amdgcn_s_setprio(0); } while (0)
#define PG8_WAIT_V(n) asm volatile("s_waitcnt vmcnt(" #n ")" ::: "memory")
#define PG8_WAIT_L(n) asm volatile("s_waitcnt lgkmcnt(" #n ")" ::: "memory")
#define PG8_BAR __builtin_amdgcn_s_barrier()
#define PG8_SCHED __builtin_amdgcn_sched_barrier(0)
    Unit cur, nxt; int ui = 0;
    if (!S.next(0, cur)) return;
    f32x4 acc[2][2][4][2];
#pragma unroll
    for (int a = 0; a < 2; ++a)
#pragma unroll
        for (int b = 0; b < 2; ++b)
#pragma unroll
            for (int m = 0; m < 4; ++m)
#pragma unroll
                for (int n = 0; n < 2; ++n) acc[a][b][m][n] = (f32x4){0.f, 0.f, 0.f, 0.f};
    bf16x8 At[4][2], B0[2][2], B1[2][2];
    const char* cA = (const char*)g.A + (size_t)cur.pm * tstepA; const char* cB = (const char*)g.Bt + (size_t)cur.pn * tstepB;
    S.a_ready(cur);
    if constexpr (SP2) {
        PG8_STAGE(PG8_SB(0, 0), cB, voffB); PG8_STAGE(PG8_SB(0, 1), cB + hstepB, voffB); PG8_STAGE(PG8_SA(0, 0), cA, voffA); PG8_STAGE(PG8_SA(0, 1), cA + hstepA, voffA);
        if (wr == 1) PG8_BAR;
        PG8_WAIT_V(2); PG8_BAR;
        PG8_STAGE(PG8_SB(1, 0), cB + kstep, voffB); PG8_STAGE(PG8_SA(1, 0), cA + kstep, voffA); PG8_STAGE(PG8_SB(1, 1), cB + hstepB + kstep, voffB);
        PG8_WAIT_V(6); PG8_BAR;
    } else {
        PG8_STAGE(PG8_SB(0, 0), cB, voffB); PG8_STAGE(PG8_SA(0, 0), cA, voffA); PG8_STAGE(PG8_SB(0, 1), cB + hstepB, voffB); PG8_STAGE(PG8_SA(0, 1), cA + hstepA, voffA);
        if (wr == 1) PG8_BAR;
        PG8_WAIT_V(4); PG8_BAR;
        PG8_STAGE(PG8_SB(1, 0), cB + kstep, voffB); PG8_STAGE(PG8_SA(1, 0), cA + kstep, voffA); PG8_STAGE(PG8_SB(1, 1), cB + hstepB + kstep, voffB);
        PG8_WAIT_V(6); PG8_BAR;
    }
    for (;;) {
        const bool has_next = S.next(ui + 1, nxt);
        const char* nA = has_next ? (const char*)g.A + (size_t)nxt.pm * tstepA : cA; const char* nB = has_next ? (const char*)g.Bt + (size_t)nxt.pn * tstepB : cB;
        for (int t = 0; t < nt; t += 2) {
            const bool last = (t == nt - 2);
            const char* a1 = cA + (size_t)(t + 1) * kstep;
            const char* a2 = last ? nA : cA + (size_t)(t + 2) * kstep; const char* b2 = last ? nB : cB + (size_t)(t + 2) * kstep;
            const char* a3 = a2 + kstep; const char* b3 = b2 + kstep;
            if (last && has_next) S.a_ready(nxt);
            if constexpr (SP2) {
            PG8_LDB(B0, 0, 0); PG8_LDB(B1, 0, 1); PG8_SCHED; PG8_LDA(At, 0, 0); PG8_STAGE(PG8_SA(1, 1), a1 + hstepA, voffA);
            PG8_WAIT_V(8); PG8_WAIT_L(0); PG8_BAR; PG8_MMA(0, 0, At, B0); PG8_MMA(0, 1, At, B1); PG8_BAR; PG8_SCHED;
            PG8_LDA(At, 0, 1); PG8_STAGE(PG8_SB(0, 0), b2, voffB); PG8_STAGE(PG8_SB(0, 1), b2 + hstepB, voffB); PG8_STAGE(PG8_SA(0, 0), a2, voffA);
            PG8_WAIT_V(8); PG8_WAIT_L(0); PG8_BAR; PG8_MMA(1, 0, At, B0); PG8_MMA(1, 1, At, B1); PG8_BAR; PG8_SCHED;
            PG8_LDB(B0, 1, 0); PG8_LDB(B1, 1, 1); PG8_SCHED; PG8_LDA(At, 1, 0); PG8_STAGE(PG8_SA(0, 1), a2 + hstepA, voffA);
            PG8_WAIT_V(8); PG8_WAIT_L(0); PG8_BAR; PG8_MMA(0, 0, At, B0); PG8_MMA(0, 1, At, B1); PG8_BAR; PG8_SCHED;
            PG8_LDA(At, 1, 1); PG8_STAGE(PG8_SB(1, 0), b3, voffB); PG8_STAGE(PG8_SB(1, 1), b3 + hstepB, voffB); PG8_STAGE(PG8_SA(1, 0), a3, voffA);
            PG8_WAIT_V(8); PG8_WAIT_L(0); PG8_BAR; PG8_MMA(1, 0, At, B0); PG8_MMA(1, 1, At, B1); PG8_BAR; PG8_SCHED;
            } else {
            PG8_LDB(B0, 0, 0); PG8_SCHED; PG8_LDA(At, 0, 0); PG8_STAGE(PG8_SA(1, 1), a1 + hstepA, voffA);
            PG8_WAIT_L(8); PG8_BAR; PG8_WAIT_L(0); PG8_MMA(0, 0, At, B0); PG8_BAR; PG8_SCHED;
            PG8_LDB(B1, 0, 1); PG8_STAGE(PG8_SB(0, 0), b2, voffB);
            PG8_BAR; PG8_WAIT_L(0); PG8_MMA(0, 1, At, B1); PG8_BAR;
            PG8_LDA(At, 0, 1); PG8_STAGE(PG8_SA(0, 0), a2, voffA);
            PG8_BAR; PG8_WAIT_L(0); PG8_MMA(1, 0, At, B0); PG8_BAR; PG8_SCHED;
            PG8_STAGE(PG8_SB(0, 1), b2 + hstepB, voffB);
            PG8_WAIT_V(6); PG8_BAR; PG8_MMA(1, 1, At, B1); PG8_BAR;
            PG8_LDB(B0, 1, 0); PG8_SCHED; PG8_LDA(At, 1, 0); PG8_STAGE(PG8_SA(0, 1), a2 + hstepA, voffA);
            PG8_WAIT_L(8); PG8_BAR; PG8_WAIT_L(0); PG8_MMA(0, 0, At, B0); PG8_BAR; PG8_SCHED;
            PG8_LDB(B1, 1, 1); PG8_STAGE(PG8_SB(1, 0), b3, voffB);
            PG8_BAR; PG8_WAIT_L(0); PG8_MMA(0, 1, At, B1); PG8_BAR;
            PG8_LDA(At, 1, 1); PG8_STAGE(PG8_SA(1, 0), a3, voffA);
            PG8_BAR; PG8_WAIT_L(0); PG8_MMA(1, 0, At, B0); PG8_BAR; PG8_SCHED;
            PG8_STAGE(PG8_SB(1, 1), b3 + hstepB, voffB);
            PG8_WAIT_V(6); PG8_BAR; PG8_MMA(1, 1, At, B1); PG8_BAR;
            }
        }
        if constexpr (ALIGN_EPI) { if (wr == 0) PG8_BAR; }
        if constexpr (!Epi::AFTER_DRAIN) { E(acc, cur, wr, wc, fr, fq); S.done(cur); }
        if (!has_next) break;
#pragma unroll
        for (int a = 0; a < 2; ++a)
#pragma unroll
            for (int b = 0; b < 2; ++b)
#pragma unroll
                for (int m = 0; m < 4; ++m)
#pragma unroll
                    for (int n = 0; n < 2; ++n) acc[a][b][m][n] = (f32x4){0.f, 0.f, 0.f, 0.f};
        cur = nxt; cA = nA; cB = nB; ++ui;
        if constexpr (ALIGN_EPI) { if (wr == 1) PG8_BAR; }
    }
    PG8_WAIT_V(0);
    if constexpr (!ALIGN_EPI) { if (wr == 0) PG8_BAR; }
    PG8_BAR;
    if constexpr (Epi::AFTER_DRAIN) { E.fused(acc, cur, wr, wc, fr, fq, lds, wid, lane); S.done(cur); }
#undef PG8_SA
#undef PG8_SB
#undef PG8_STAGE
#undef PG8_LDA
#undef PG8_LDB
#undef PG8_MMA
#undef PG8_WAIT_V
#undef PG8_WAIT_L
#undef PG8_BAR
#undef PG8_SCHED
}
}

typedef unsigned short bf16_t;
constexpr int DM = 2048, NB = 2, SEQ = 4096, MTOK = NB * SEQ;
constexpr int SGW_ = 1024, QW = 1024, KVW = 256, INW = 7680, DFF = 5632, UPW = 2 * DFF;
constexpr float EPS = 1e-6f;
constexpr float LOG2E = 1.4426950408889634f;
constexpr float QSCALE = 0.08838834764831845f * 1.4426950408889634f;
constexpr size_t MiB = 1u << 20;
constexpr size_t WS_CTL = 0;
constexpr size_t WS_ROPE = 1 * MiB;
constexpr size_t WS_WIN = 4 * MiB, WS_WAB = 34 * MiB, WS_WO = 42 * MiB, WS_WUP = 50 * MiB, WS_WDN = 94 * MiB;
constexpr size_t WS_XN = 117 * MiB;
constexpr size_t WS_GU = 117 * MiB, WS_VN = 133 * MiB, WS_MG = 117 * MiB, WS_H = 117 * MiB;
constexpr size_t WS_Q = 4 * MiB, WS_K = 20 * MiB, WS_V = 24 * MiB;
constexpr size_t WS_Z = 149 * MiB;
constexpr size_t WS_AB = 149 * MiB, WS_P1 = 181 * MiB, WS_Y = 149 * MiB;
constexpr size_t WS_RA = 269 * MiB, WS_SB = 301 * MiB;
constexpr size_t WS_HF = 213 * MiB;
constexpr size_t WS_U = 246 * MiB, WS_F = 246 * MiB;
constexpr size_t WS_END = 334 * MiB;

#define DEV __device__ __forceinline__
DEV float bf2f(bf16_t v) { return __uint_as_float(((unsigned)v) << 16); }
DEV bf16_t f2bf(float f) { unsigned u = __float_as_uint(f); return (bf16_t)((u + 0x7fffu + ((u >> 16) & 1u)) >> 16); }
DEV unsigned pk2(float lo, float hi) { return (unsigned)f2bf(lo) | ((unsigned)f2bf(hi) << 16); }
DEV float gelu_tanh(float x) { const float u = 0.7978845608028654f * (x + 0.044715f * x * x * x); return x / (1.f + __expf(-2.f * u)); }
DEV float sigmoid_f(float g) { return 1.f / (1.f + __expf(-g)); }
DEV float wave_sum(float v) {
#pragma unroll
    for (int o = 1; o < 64; o <<= 1) v += __shfl_xor(v, o);
    return v;
}
DEV int colmap(int mode, int n) {
    if (mode == 1) { if (n < 3584) return n; const int j = (n - 3584) >> 8, c = (n - 3584) & 255; return c < 128 ? 3584 + 128 * j + c : 3584 + 2048 + 128 * j + (c - 128); }
    if (mode == 2) { const int j = n >> 8, c = n & 255; return c < 128 ? 128 * j + c : DFF + 128 * j + (c - 128); }
    return n;
}
__global__ void __launch_bounds__(256) k_transpose(const float* __restrict__ W, bf16_t* __restrict__ WT, int K, int N, int ndst, int ldk, int koff, int mode) {
    __shared__ float scr_all[4][64 * 33];
    const int lane = threadIdx.x & 63, wave = threadIdx.x >> 6; float* scr = scr_all[wave];
    const int nblk = ndst / 32, nitems = (K / 64) * nblk;
    for (int item = blockIdx.x * 4 + wave; item < nitems; item += gridDim.x * 4) {
        const int kb = item / nblk, nb = item % nblk, k0 = 64 * kb, n0 = 32 * nb, s0 = colmap(mode, n0);
#pragma unroll 8
        for (int i = 0; i < 32; ++i) { const int kk = 2 * i + (lane >> 5); scr[kk * 33 + (lane & 31)] = W[(size_t)(k0 + kk) * N + s0 + (lane & 31)]; }
        __builtin_amdgcn_wave_barrier(); asm volatile("s_waitcnt lgkmcnt(0)" ::: "memory");
        const int c = lane & 7;
#pragma unroll
        for (int j = 0; j < 4; ++j) { const int n = (lane >> 3) + 8 * j; const float* s = scr + (8 * c) * 33 + n;
            uint4 o; o.x = pk2(s[0 * 33], s[1 * 33]); o.y = pk2(s[2 * 33], s[3 * 33]); o.z = pk2(s[4 * 33], s[5 * 33]); o.w = pk2(s[6 * 33], s[7 * 33]);
            *(uint4*)(WT + (size_t)(n0 + n) * ldk + koff + k0 + 8 * c) = o; }
        __builtin_amdgcn_wave_barrier(); asm volatile("s_waitcnt lgkmcnt(0)" ::: "memory");
    }
}
__global__ void __launch_bounds__(256) k_rms_in(const float* __restrict__ x, const float* __restrict__ g, bf16_t* __restrict__ out) {
    const int lane = threadIdx.x & 63, row = blockIdx.x * 4 + (threadIdx.x >> 6);
    const float4* xr = (const float4*)(x + (size_t)row * DM); const float4* gr = (const float4*)g;
    float4 v[8]; float ss = 0.f;
#pragma unroll
    for (int j = 0; j < 8; ++j) { v[j] = xr[lane + 64 * j]; ss += v[j].x * v[j].x + v[j].y * v[j].y + v[j].z * v[j].z + v[j].w * v[j].w; }
    const float r = rsqrtf(wave_sum(ss) * (1.f / DM) + EPS);
    uint2* o = (uint2*)(out + (size_t)row * DM);
#pragma unroll
    for (int j = 0; j < 8; ++j) { const float4 gg = gr[lane + 64 * j]; uint2 w; w.x = pk2(v[j].x * r * gg.x, v[j].y * r * gg.y); w.y = pk2(v[j].z * r * gg.z, v[j].w * r * gg.w); o[lane + 64 * j] = w; }
}
__device__ const float INV_FREQ[16] = {1.000000000e+00f, 4.403665960e-01f, 1.939227432e-01f, 8.539710194e-02f, 3.760603070e-02f, 1.656043902e-02f, 7.292664610e-03f, 3.211445874e-03f,
                                       1.414213562e-03f, 6.227723788e-04f, 2.742481884e-04f, 1.207697351e-04f, 5.318296098e-05f, 2.341999971e-05f, 1.031338616e-05f, 4.541670478e-06f};
__global__ void __launch_bounds__(256) k_rope_table(float* __restrict__ cosT, float* __restrict__ sinT) {
    const int idx = blockIdx.x * 256 + threadIdx.x; if (idx >= SEQ * 16) return;
    const int pos = idx >> 4, i = idx & 15; const float ang = (float)pos * INV_FREQ[i];
    cosT[idx] = (float)cos((double)ang); sinT[idx] = (float)sin((double)ang);
}
__global__ void __launch_bounds__(256) k_post1(const bf16_t* __restrict__ Z, const float* __restrict__ ln_g, const float* __restrict__ ln_b, const float* __restrict__ cosT, const float* __restrict__ sinT,
                                               bf16_t* __restrict__ GU, bf16_t* __restrict__ VN, bf16_t* __restrict__ Q, bf16_t* __restrict__ Kb, bf16_t* __restrict__ Vb, bf16_t* __restrict__ RA, bf16_t* __restrict__ SB) {
    const int lane = threadIdx.x & 63, row = blockIdx.x * 4 + (threadIdx.x >> 6), pos = row % SEQ;
    const bf16_t* z = Z + (size_t)row * INW;
    for (int c = lane; c < 1024; c += 64) GU[(size_t)row * 1024 + c] = f2bf(gelu_tanh(bf2f(z[c])));
    float gv[16]; float s = 0.f;
#pragma unroll
    for (int j = 0; j < 16; ++j) { gv[j] = gelu_tanh(bf2f(z[1024 + lane + 64 * j])); s += gv[j]; }
    const float mean = wave_sum(s) * (1.f / 1024.f); float q = 0.f;
#pragma unroll
    for (int j = 0; j < 16; ++j) { const float d = gv[j] - mean; q += d * d; }
    const float rstd = rsqrtf(wave_sum(q) * (1.f / 1024.f) + EPS);
#pragma unroll
    for (int j = 0; j < 16; ++j) { const int c = lane + 64 * j; VN[(size_t)row * 1024 + c] = f2bf((gv[j] - mean) * rstd * ln_g[c] + ln_b[c]); }
    for (int c = lane; c < 1024 + 256; c += 64) {
        const bool isq = c < 1024; const int cc = isq ? c : c - 1024, base = isq ? 2048 : 3072, d = cc & 127, hb = base + (cc & ~127); float val;
        if (d < 32) { const int i = d & 15; const float x1 = bf2f(z[hb + i]), x2 = bf2f(z[hb + 16 + i]), cs = cosT[pos * 16 + i], sn = sinT[pos * 16 + i]; val = d < 16 ? x1 * cs - x2 * sn : x2 * cs + x1 * sn; }
        else val = bf2f(z[hb + d]);
        if (isq) Q[(size_t)row * 1024 + cc] = f2bf(val * QSCALE); else Kb[(size_t)row * 256 + cc] = f2bf(val);
    }
    for (int c = lane; c < 256; c += 64) Vb[(size_t)row * 256 + c] = z[3328 + c];
    for (int c = lane; c < 2048; c += 64) { const int j = c >> 7, i = c & 127; const float gA = bf2f(z[3584 + 256 * j + i]), gB = bf2f(z[3584 + 256 * j + 128 + i]);
        const float sA = sigmoid_f(gA), sB = sigmoid_f(gB); RA[(size_t)row * 2048 + c] = f2bf(sA / sB); SB[(size_t)row * 2048 + c] = f2bf(sB); }
}
__global__ void __launch_bounds__(256) k_sg_naive(const bf16_t* __restrict__ GU, const bf16_t* __restrict__ VN, const float* __restrict__ sgw, const float* __restrict__ sgb, bf16_t* __restrict__ AB) {
    const int col = blockIdx.x * 256 + threadIdx.x, row = blockIdx.y, g = col >> 7, t = row & 127, cb = row - t;
    const float* w = sgw + (size_t)(g * 128 + t) * 128; float acc = 0.f;
    for (int s = 0; s < 128; ++s) acc += w[s] * bf2f(VN[(size_t)(cb + s) * 1024 + col]);
    acc += sgb[g * 128 + t];
    AB[(size_t)row * 2048 + col] = f2bf(bf2f(GU[(size_t)row * 1024 + col]) * acc);
}
__global__ void __launch_bounds__(256) k_attn_naive(const bf16_t* __restrict__ Q, const bf16_t* __restrict__ Kb, const bf16_t* __restrict__ Vb, const float* __restrict__ sink, bf16_t* __restrict__ AB) {
    const int lane = threadIdx.x & 63, idx = blockIdx.x * 4 + (threadIdx.x >> 6), row = idx >> 3, h = idx & 7, kvh = h >> 2, b = row / SEQ, pos = row % SEQ;
    const unsigned qq = *(const unsigned*)(Q + (size_t)row * 1024 + h * 128 + 2 * lane); const float q0 = __uint_as_float(qq << 16), q1 = __uint_as_float(qq & 0xffff0000u);
    float m = sink[h] * LOG2E, l = 1.f, o0 = 0.f, o1 = 0.f;
    const int klo = pos - 128 < 0 ? 0 : pos - 128, khi = pos + 128 > SEQ - 1 ? SEQ - 1 : pos + 128;
    for (int kp = klo; kp <= khi; ++kp) { const size_t kr = (size_t)(b * SEQ + kp) * 256 + kvh * 128 + 2 * lane;
        const unsigned kk = *(const unsigned*)(Kb + kr), vv = *(const unsigned*)(Vb + kr);
        const float s = wave_sum(q0 * __uint_as_float(kk << 16) + q1 * __uint_as_float(kk & 0xffff0000u));
        const float mn = fmaxf(m, s), a = exp2f(m - mn), p = exp2f(s - mn);
        l = l * a + p; o0 = o0 * a + p * __uint_as_float(vv << 16); o1 = o1 * a + p * __uint_as_float(vv & 0xffff0000u); m = mn; }
    const float il = 1.f / l;
    *(unsigned*)(AB + (size_t)row * 2048 + 1024 + h * 128 + 2 * lane) = pk2(o0 * il, o1 * il);
}
__global__ void __launch_bounds__(256) k_post4(const float* __restrict__ Y, const float* __restrict__ x, const float* __restrict__ g1, const float* __restrict__ g2, float* __restrict__ out, bf16_t* __restrict__ HF) {
    const int lane = threadIdx.x & 63, row = blockIdx.x * 4 + (threadIdx.x >> 6);
    const float4* yr = (const float4*)(Y + (size_t)row * DM); const float4* xr = (const float4*)(x + (size_t)row * DM);
    float4 v[8]; float ss = 0.f;
#pragma unroll
    for (int j = 0; j < 8; ++j) { v[j] = yr[lane + 64 * j]; ss += v[j].x * v[j].x + v[j].y * v[j].y + v[j].z * v[j].z + v[j].w * v[j].w; }
    const float r1 = rsqrtf(wave_sum(ss) * (1.f / DM) + EPS); float s2 = 0.f;
#pragma unroll
    for (int j = 0; j < 8; ++j) { const float4 gg = ((const float4*)g1)[lane + 64 * j], xx = xr[lane + 64 * j];
        v[j].x = xx.x + v[j].x * r1 * gg.x; v[j].y = xx.y + v[j].y * r1 * gg.y; v[j].z = xx.z + v[j].z * r1 * gg.z; v[j].w = xx.w + v[j].w * r1 * gg.w;
        s2 += v[j].x * v[j].x + v[j].y * v[j].y + v[j].z * v[j].z + v[j].w * v[j].w; ((float4*)(out + (size_t)row * DM))[lane + 64 * j] = v[j]; }
    const float r2 = rsqrtf(wave_sum(s2) * (1.f / DM) + EPS);
#pragma unroll
    for (int j = 0; j < 8; ++j) { const float4 gg = ((const float4*)g2)[lane + 64 * j]; uint2 w; w.x = pk2(v[j].x * r2 * gg.x, v[j].y * r2 * gg.y); w.y = pk2(v[j].z * r2 * gg.z, v[j].w * r2 * gg.w);
        ((uint2*)(HF + (size_t)row * DM))[lane + 64 * j] = w; }
}
__global__ void __launch_bounds__(256) k_conv_naive(const bf16_t* __restrict__ U, const float* __restrict__ cw, const float* __restrict__ cb, bf16_t* __restrict__ H) {
    const int cc = blockIdx.x * 256 + threadIdx.x, t = blockIdx.y, j = cc >> 7, c = cc & 127, gcol = 256 * j + c, vcol = gcol + 128, og = cc, ov = DFF + cc;
    float cg = cb[og], cv = cb[ov];
#pragma unroll
    for (int jj = 0; jj < 3; ++jj) { const int tt = t + jj - 1; if (tt >= 0 && tt < SEQ) { cg += cw[jj * UPW + og] * bf2f(U[(size_t)tt * UPW + gcol]); cv += cw[jj * UPW + ov] * bf2f(U[(size_t)tt * UPW + vcol]); } }
    H[(size_t)t * DFF + cc] = f2bf(gelu_tanh(cg) * cv);
}
__global__ void __launch_bounds__(256) k_post6(const float* __restrict__ F, const float* __restrict__ g, float* __restrict__ out) {
    const int lane = threadIdx.x & 63, row = blockIdx.x * 4 + (threadIdx.x >> 6);
    const float4* fr = (const float4*)(F + (size_t)row * DM); float4* orow = (float4*)(out + (size_t)row * DM);
    float4 v[8]; float ss = 0.f;
#pragma unroll
    for (int j = 0; j < 8; ++j) { v[j] = fr[lane + 64 * j]; ss += v[j].x * v[j].x + v[j].y * v[j].y + v[j].z * v[j].z + v[j].w * v[j].w; }
    const float r = rsqrtf(wave_sum(ss) * (1.f / DM) + EPS);
#pragma unroll
    for (int j = 0; j < 8; ++j) { const float4 gg = ((const float4*)g)[lane + 64 * j]; float4 xx = orow[lane + 64 * j];
        xx.x += v[j].x * r * gg.x; xx.y += v[j].y * r * gg.y; xx.z += v[j].z * r * gg.z; xx.w += v[j].w * r * gg.w; orow[lane + 64 * j] = xx; }
}

template <class Epi> struct GArgs { pg8::Gemm g; Epi e; };
template <class Epi> __global__ void __launch_bounds__(512, 2) k_gemm(GArgs<Epi> a) {
    extern __shared__ __attribute__((aligned(16))) unsigned char lds[];
    pg8::StaticOrder S; S.init(a.g.M, a.g.N, (int)gridDim.x, (int)blockIdx.x);
    pg8::gemm_phase<Epi, pg8::StaticOrder, true, true>((PG8_LAS unsigned char*)lds, a.g, S, a.e);
}
template <class Epi> static void launch_gemm(hipStream_t st, const bf16_t* A, int lda, const bf16_t* Bt, int ldb, int M, int N, int K, const Epi& e) {
    static bool attr = false;
    if (!attr) { (void)hipFuncSetAttribute((const void*)k_gemm<Epi>, hipFuncAttributeMaxDynamicSharedMemorySize, pg8::STAGE_BYTES); attr = true; }
    GArgs<Epi> a{}; a.g.A = A; a.g.Bt = Bt; a.g.M = M; a.g.N = N; a.g.K = K; a.g.lda = lda; a.g.ldb = ldb; a.g.pad = 0; a.e = e;
    hipLaunchKernelGGL(k_gemm<Epi>, dim3(256), dim3(512), pg8::STAGE_BYTES, st, a);
}

extern "C" void kernel_launch(void* const* d_in, const int* in_sizes, int n_in, void* d_out, int out_size, void* d_ws, size_t ws_size, hipStream_t stream) {
    (void)in_sizes; (void)n_in; (void)out_size;
    if (ws_size < WS_END) { fprintf(stderr, "kernel_launch: workspace too small (%zu < %zu)\n", ws_size, (size_t)WS_END); return; }
    const float* x = (const float*)d_in[0]; const float* norm_mix_pre = (const float*)d_in[1]; const float* w_in = (const float*)d_in[2];
    const float* sg_ln_g = (const float*)d_in[3]; const float* sg_ln_b = (const float*)d_in[4]; const float* sg_w = (const float*)d_in[5]; const float* sg_b = (const float*)d_in[6];
    const float* attn_sink = (const float*)d_in[7]; const float* w_a = (const float*)d_in[8]; const float* w_b = (const float*)d_in[9]; const float* w_out = (const float*)d_in[10];
    const float* norm_mix_post = (const float*)d_in[11]; const float* norm_ffn_pre = (const float*)d_in[12]; const float* w_up = (const float*)d_in[13];
    const float* conv_w = (const float*)d_in[14]; const float* conv_b = (const float*)d_in[15]; const float* w_down = (const float*)d_in[16]; const float* norm_ffn_post = (const float*)d_in[17];
    float* out = (float*)d_out; unsigned char* ws = (unsigned char*)d_ws;
    bf16_t* WinT = (bf16_t*)(ws + WS_WIN); bf16_t* WabT = (bf16_t*)(ws + WS_WAB); bf16_t* WoT = (bf16_t*)(ws + WS_WO); bf16_t* WupT = (bf16_t*)(ws + WS_WUP); bf16_t* WdT = (bf16_t*)(ws + WS_WDN);
    bf16_t* XN = (bf16_t*)(ws + WS_XN); bf16_t* Z = (bf16_t*)(ws + WS_Z); bf16_t* GU = (bf16_t*)(ws + WS_GU); bf16_t* VN = (bf16_t*)(ws + WS_VN);
    bf16_t* Q = (bf16_t*)(ws + WS_Q); bf16_t* Kb = (bf16_t*)(ws + WS_K); bf16_t* Vb = (bf16_t*)(ws + WS_V); bf16_t* RA = (bf16_t*)(ws + WS_RA); bf16_t* SB = (bf16_t*)(ws + WS_SB);
    bf16_t* AB = (bf16_t*)(ws + WS_AB); float* P1 = (float*)(ws + WS_P1); bf16_t* MG = (bf16_t*)(ws + WS_MG); float* Y = (float*)(ws + WS_Y); bf16_t* HF = (bf16_t*)(ws + WS_HF);
    bf16_t* U = (bf16_t*)(ws + WS_U); bf16_t* H = (bf16_t*)(ws + WS_H); float* F = (float*)(ws + WS_F);
    float* cosT = (float*)(ws + WS_ROPE); float* sinT = cosT + SEQ * 16;
    hipLaunchKernelGGL(k_transpose, dim3(2048), dim3(256), 0, stream, w_in, WinT, DM, INW, INW, DM, 0, 1);
    hipLaunchKernelGGL(k_transpose, dim3(1024), dim3(256), 0, stream, w_a, WabT, 1024, DM, DM, 2048, 0, 0);
    hipLaunchKernelGGL(k_transpose, dim3(1024), dim3(256), 0, stream, w_b, WabT, 1024, DM, DM, 2048, 1024, 0);
    hipLaunchKernelGGL(k_transpose, dim3(1024), dim3(256), 0, stream, w_out, WoT, DM, DM, DM, DM, 0, 0);
    hipLaunchKernelGGL(k_transpose, dim3(2048), dim3(256), 0, stream, w_up, WupT, DM, UPW, UPW, DM, 0, 2);
    hipLaunchKernelGGL(k_transpose, dim3(2048), dim3(256), 0, stream, w_down, WdT, DFF, DM, DM, DFF, 0, 0);
    hipLaunchKernelGGL(k_rms_in, dim3(MTOK / 4), dim3(256), 0, stream, x, norm_mix_pre, XN);
    hipLaunchKernelGGL(k_rope_table, dim3(SEQ * 16 / 256), dim3(256), 0, stream, cosT, sinT);
    { pg8::EpiBf16Plain e{}; e.O = Z; e.ldc = INW; launch_gemm(stream, XN, DM, WinT, DM, MTOK, INW, DM, e); }
    hipLaunchKernelGGL(k_post1, dim3(MTOK / 4), dim3(256), 0, stream, Z, sg_ln_g, sg_ln_b, cosT, sinT, GU, VN, Q, Kb, Vb, RA, SB);
    hipLaunchKernelGGL(k_sg_naive, dim3(4, MTOK), dim3(256), 0, stream, GU, VN, sg_w, sg_b, AB);
    hipLaunchKernelGGL(k_attn_naive, dim3(MTOK * 8 / 4), dim3(256), 0, stream, Q, Kb, Vb, attn_sink, AB);
    { pg8::EpiF32 e{}; e.O = P1; e.S = RA; e.ldc = DM; e.lds_ = DM; launch_gemm(stream, AB, 2048, WabT, 2048, MTOK, DM, 1024, e); }
    { pg8::EpiMerge e{}; e.O = MG; e.P = P1; e.S = SB; e.ldc = DM; launch_gemm(stream, AB + 1024, 2048, WabT + 1024, 2048, MTOK, DM, 1024, e); }
    { pg8::EpiF32 e{}; e.O = Y; e.S = nullptr; e.ldc = DM; e.lds_ = 0; launch_gemm(stream, MG, DM, WoT, DM, MTOK, DM, DM, e); }
    hipLaunchKernelGGL(k_post4, dim3(MTOK / 4), dim3(256), 0, stream, Y, x, norm_mix_post, norm_ffn_pre, out, HF);
    for (int b = 0; b < NB; ++b) {
        pg8::EpiBf16Plain e{}; e.O = U; e.ldc = UPW; launch_gemm(stream, HF + (size_t)b * SEQ * DM, DM, WupT, DM, SEQ, UPW, DM, e);
        hipLaunchKernelGGL(k_conv_naive, dim3(DFF / 256, SEQ), dim3(256), 0, stream, U, conv_w, conv_b, H + (size_t)b * SEQ * DFF);
    }
    { pg8::EpiF32 e{}; e.O = F; e.S = nullptr; e.ldc = DM; e.lds_ = 0; launch_gemm(stream, H, DFF, WdT, DFF, MTOK, DM, DFF, e); }
    hipLaunchKernelGGL(k_post6, dim3(MTOK / 4), dim3(256), 0, stream, F, norm_ffn_post, out);
}
```

```cpp
#include <hip/hip_runtime.h>
#include <cstdio>
#include <cstdint>
namespace pg8 {
#define PG8_LAS __attribute__((address_space(3)))
typedef unsigned short bf16_t;
typedef short bf16x8 __attribute__((ext_vector_type(8)));
typedef float f32x4 __attribute__((ext_vector_type(4)));
typedef unsigned u32x4 __attribute__((ext_vector_type(4)));
constexpr int BM = 256, BK = 64, HALF = 128, HTB = HALF * BK * 2  , STAGE_BYTES = 8 * HTB, NXCD = 8, WGM = 8;

__host__ __device__ __forceinline__ int lds_byte(int r, int c) { const int st = (r >> 4) * 2 + (c >> 5), rr = r & 15, cc = c & 31, ob = rr * 64 + cc * 2; return st * 1024 + (ob ^ (((ob >> 9) & 1) << 5)); }
__host__ __device__ __forceinline__ void stage_rc(int b, int& R, int& C) { const int st = b / 1024, sb = b % 1024, swz = sb ^ (((sb >> 9) & 1) << 5); R = (st >> 1) * 16 + swz / 64; C = (st & 1) * 32 + (swz % 64) / 2; }
__host__ __device__ __forceinline__ int perm32(int rho) { const int n = rho >> 4, i = rho & 15; return 8 * (i >> 2) + 4 * n + (i & 3); }

struct Unit { int pm, pn; };
struct Gemm { const bf16_t* A; const bf16_t* Bt; int M, N, K, lda, ldb, pad; };

struct StaticOrder {
    int nM, nN, nwg, G, c;
    __host__ __device__ void init(int M, int N, int G_, int c_) { nM = M / BM; nN = N / BM; nwg = nM * nN; G = G_; c = c_; }
    __host__ __device__ bool next(int i, Unit& u) const {
        const long L = (long)i * G + c; if (L >= nwg) return false;
        int wgid = (int)L; { const int q = nwg / NXCD, r = nwg % NXCD, xcd = wgid % NXCD, off = wgid / NXCD; wgid = (xcd < r ? xcd * (q + 1) : r * (q + 1) + (xcd - r) * q) + off; }
        const int nig = WGM * nN, gid = wgid / nig, fm = gid * WGM, gsz = (nM - fm) < WGM ? (nM - fm) : WGM;
        u.pm = fm + ((wgid % nig) % gsz); u.pn = (wgid % nig) / gsz; return true;
    }
    __device__ __forceinline__ void a_ready(const Unit&) const {}
    __device__ __forceinline__ void done(const Unit&) const {}
};


__device__ __forceinline__ unsigned cvt_pk_bf16(float lo, float hi) { unsigned r; asm volatile("v_cvt_pk_bf16_f32 %0, %1, %2" : "=v"(r) : "v"(lo), "v"(hi)); return r; }
typedef unsigned u32x2 __attribute__((ext_vector_type(2)));

struct EpiBf16Plain {
    static constexpr bool PERM = true, AFTER_DRAIN = false;
    bf16_t* O; int ldc, pad;
    __device__ __forceinline__ void operator()(const f32x4 (&acc)[2][2][4][2], const Unit& u, int wr, int wc, int fr, int fq) const {
        const int row0 = u.pm * BM + wr * 64 + fr, col0 = u.pn * BM + wc * 32 + 8 * fq;
#pragma unroll
        for (int ai = 0; ai < 2; ++ai)
#pragma unroll
            for (int m = 0; m < 4; ++m) { bf16_t* rowp = O + (size_t)(row0 + ai * HALF + m * 16) * ldc + col0;
#pragma unroll
                for (int bj = 0; bj < 2; ++bj) { const f32x4 v0 = acc[ai][bj][m][0], v1 = acc[ai][bj][m][1];
                    u32x4 w; w.x = cvt_pk_bf16(v0[0], v0[1]); w.y = cvt_pk_bf16(v0[2], v0[3]); w.z = cvt_pk_bf16(v1[0], v1[1]); w.w = cvt_pk_bf16(v1[2], v1[3]);
                    *(u32x4*)(rowp + bj * HALF) = w; } }
    }
};
__device__ __forceinline__ float bfbits2f(unsigned short v) { return __uint_as_float(((unsigned)v) << 16); }
struct EpiF32 {
    static constexpr bool PERM = false, AFTER_DRAIN = false;
    float* O; const bf16_t* S; int ldc, lds_;
    __device__ __forceinline__ void operator()(const f32x4 (&acc)[2][2][4][2], const Unit& u, int wr, int wc, int fr, int fq) const {
        const int row0 = u.pm * BM + wr * 64 + fr, col0 = u.pn * BM + wc * 32 + 4 * fq;
#pragma unroll
        for (int ai = 0; ai < 2; ++ai)
#pragma unroll
            for (int m = 0; m < 4; ++m) { const size_t r = (size_t)(row0 + ai * HALF + m * 16);
#pragma unroll
                for (int bj = 0; bj < 2; ++bj)
#pragma unroll
                    for (int n = 0; n < 2; ++n) { f32x4 v = acc[ai][bj][m][n]; const int c = col0 + bj * HALF + n * 16;
                        if (S) { const u32x2 s = *(const u32x2*)(S + r * lds_ + c);
                            v[0] *= __uint_as_float(s.x << 16); v[1] *= __uint_as_float(s.x & 0xffff0000u); v[2] *= __uint_as_float(s.y << 16); v[3] *= __uint_as_float(s.y & 0xffff0000u); }
                        *(f32x4*)(O + r * ldc + c) = v; } }
    }
};
struct EpiMerge {
    static constexpr bool PERM = false, AFTER_DRAIN = false;
    bf16_t* O; const float* P; const bf16_t* S; int ldc, pad;
    __device__ __forceinline__ void operator()(const f32x4 (&acc)[2][2][4][2], const Unit& u, int wr, int wc, int fr, int fq) const {
        const int row0 = u.pm * BM + wr * 64 + fr, col0 = u.pn * BM + wc * 32 + 4 * fq;
#pragma unroll
        for (int ai = 0; ai < 2; ++ai)
#pragma unroll
            for (int m = 0; m < 4; ++m) { const size_t r = (size_t)(row0 + ai * HALF + m * 16);
#pragma unroll
                for (int bj = 0; bj < 2; ++bj)
#pragma unroll
                    for (int n = 0; n < 2; ++n) { const int c = col0 + bj * HALF + n * 16; f32x4 v = acc[ai][bj][m][n] + *(const f32x4*)(P + r * ldc + c);
                        const u32x2 s = *(const u32x2*)(S + r * ldc + c);
                        v[0] *= __uint_as_float(s.x << 16); v[1] *= __uint_as_float(s.x & 0xffff0000u); v[2] *= __uint_as_float(s.y << 16); v[3] *= __uint_as_float(s.y & 0xffff0000u);
                        u32x2 w; w.x = cvt_pk_bf16(v[0], v[1]); w.y = cvt_pk_bf16(v[2], v[3]); *(u32x2*)(O + r * ldc + c) = w; } }
    }
};

template <class Epi, class Sched, bool ALIGN_EPI = false, bool SP2 = false>
__device__ __forceinline__ void gemm_phase(PG8_LAS unsigned char* lds, const Gemm g, const Sched& S, const Epi& E) {
    int tid_ = threadIdx.x; asm volatile("" : "+v"(tid_));
    const int tid = tid_, wid = __builtin_amdgcn_readfirstlane(tid >> 6), lane = tid & 63, wr = wid >> 2, wc = wid & 3, fr = lane & 15, fq = lane >> 4;
    const int K = g.K, nt = K / BK;
    unsigned voffA[2], voffB[2];
#pragma unroll
    for (int i = 0; i < 2; ++i) { int R, C; stage_rc(tid * 16 + i * 8192, R, C); const int Rb = Epi::PERM ? ((R & ~31) + perm32(R & 31)) : R;
        voffA[i] = (unsigned)(R * g.lda + C) * 2u; voffB[i] = (unsigned)(Rb * g.ldb + C) * 2u; }
    const size_t kstep = (size_t)(BK * 2);
    const size_t hstepA = (size_t)HALF * g.lda * 2, hstepB = (size_t)HALF * g.ldb * 2;
    const size_t tstepA = 2 * hstepA, tstepB = 2 * hstepB;
    const unsigned ldsw = (unsigned)wid * 1024u;
    const int aoff = lds_byte(wr * 64 + fr, fq * 8), boff = lds_byte(wc * 32 + fr, fq * 8);
#define PG8_SA(b, h) (((b) * 2 + (h)) * HTB)
#define PG8_SB(b, h) ((4 + (b) * 2 + (h)) * HTB)
#define PG8_STAGE(bufoff, gbase, voff) do { _Pragma("unroll") for (int _i = 0; _i < 2; ++_i) \
        __builtin_amdgcn_global_load_lds((const unsigned*)((const char*)(gbase) + (voff)[_i]), (PG8_LAS unsigned*)(lds + (bufoff) + ldsw + _i * 8192), 16, 0, 0); } while (0)
#define PG8_LDA(dst, b, h) do { _Pragma("unroll") for (int m = 0; m < 4; ++m) _Pragma("unroll") for (int k = 0; k < 2; ++k) dst[m][k] = *(const PG8_LAS bf16x8*)(lds + PG8_SA(b, h) + aoff + m * 2048 + k * 1024); } while (0)
#define PG8_LDB(dst, b, h) do { _Pragma("unroll") for (int n = 0; n < 2; ++n) _Pragma("unroll") for (int k = 0; k < 2; ++k) dst[n][k] = *(const PG8_LAS bf16x8*)(lds + PG8_SB(b, h) + boff + n * 2048 + k * 1024); } while (0)
#define PG8_MMA(ai, bj, At, Bt) do { __builtin_amdgcn_s_setprio(1); _Pragma("unroll") for (int m = 0; m < 4; ++m) _Pragma("unroll") for (int n = 0; n < 2; ++n) _Pragma("unroll") for (int k = 0; k < 2; ++k) \
        acc[ai][bj][m][n] = __builtin_amdgcn_mfma_f32_16x16x32_bf16(Bt[n][k], At[m][k], acc[ai][bj][m][n], 0, 0, 0); __builtin_amdgcn_s_setprio(0); } while (0)
#define PG8_WAIT_V(n) asm volatile("s_waitcnt vmcnt(" #n ")" ::: "memory")
#define PG8_WAIT_L(n) asm volatile("s_waitcnt lgkmcnt(" #n ")" ::: "memory")
#define PG8_BAR __builtin_amdgcn_s_barrier()
#define PG8_SCHED __builtin_amdgcn_sched_barrier(0)
    Unit cur, nxt; int ui = 0;
    if (!S.next(0, cur)) return;
    f32x4 acc[2][2][4][2];
#pragma unroll
    for (int a = 0; a < 2; ++a)
#pragma unroll
        for (int b = 0; b < 2; ++b)
#pragma unroll
            for (int m = 0; m < 4; ++m)
#pragma unroll
                for (int n = 0; n < 2; ++n) acc[a][b][m][n] = (f32x4){0.f, 0.f, 0.f, 0.f};
    bf16x8 At[4][2], B0[2][2], B1[2][2];
    const char* cA = (const char*)g.A + (size_t)cur.pm * tstepA; const char* cB = (const char*)g.Bt + (size_t)cur.pn * tstepB;
    S.a_ready(cur);
    if constexpr (SP2) {
        PG8_STAGE(PG8_SB(0, 0), cB, voffB); PG8_STAGE(PG8_SB(0, 1), cB + hstepB, voffB); PG8_STAGE(PG8_SA(0, 0), cA, voffA); PG8_STAGE(PG8_SA(0, 1), cA + hstepA, voffA);
        if (wr == 1) PG8_BAR;
        PG8_WAIT_V(2); PG8_BAR;
        PG8_STAGE(PG8_SB(1, 0), cB + kstep, voffB); PG8_STAGE(PG8_SA(1, 0), cA + kstep, voffA); PG8_STAGE(PG8_SB(1, 1), cB + hstepB + kstep, voffB);
        PG8_WAIT_V(6); PG8_BAR;
    } else {
        PG8_STAGE(PG8_SB(0, 0), cB, voffB); PG8_STAGE(PG8_SA(0, 0), cA, voffA); PG8_STAGE(PG8_SB(0, 1), cB + hstepB, voffB); PG8_STAGE(PG8_SA(0, 1), cA + hstepA, voffA);
        if (wr == 1) PG8_BAR;
        PG8_WAIT_V(4); PG8_BAR;
        PG8_STAGE(PG8_SB(1, 0), cB + kstep, voffB); PG8_STAGE(PG8_SA(1, 0), cA + kstep, voffA); PG8_STAGE(PG8_SB(1, 1), cB + hstepB + kstep, voffB);
        PG8_WAIT_V(6); PG8_BAR;
    }
    for (;;) {
        const bool has_next = S.next(ui + 1, nxt);
        const char* nA = has_next ? (const char*)g.A + (size_t)nxt.pm * tstepA : cA; const char* nB = has_next ? (const char*)g.Bt + (size_t)nxt.pn * tstepB : cB;
        for (int t = 0; t < nt; t += 2) {
            const bool last = (t == nt - 2);
            const char* a1 = cA + (size_t)(t + 1) * kstep;
            const char* a2 = last ? nA : cA + (size_t)(t + 2) * kstep; const char* b2 = last ? nB : cB + (size_t)(t + 2) * kstep;
            const char* a3 = a2 + kstep; const char* b3 = b2 + kstep;
            if (last && has_next) S.a_ready(nxt);
            if constexpr (SP2) {
            PG8_LDB(B0, 0, 0); PG8_LDB(B1, 0, 1); PG8_SCHED; PG8_LDA(At, 0, 0); PG8_STAGE(PG8_SA(1, 1), a1 + hstepA, voffA);
            PG8_WAIT_V(8); PG8_WAIT_L(0); PG8_BAR; PG8_MMA(0, 0, At, B0); PG8_MMA(0, 1, At, B1); PG8_BAR; PG8_SCHED;
            PG8_LDA(At, 0, 1); PG8_STAGE(PG8_SB(0, 0), b2, voffB); PG8_STAGE(PG8_SB(0, 1), b2 + hstepB, voffB); PG8_STAGE(PG8_SA(0, 0), a2, voffA);
            PG8_WAIT_V(8); PG8_WAIT_L(0); PG8_BAR; PG8_MMA(1, 0, At, B0); PG8_MMA(1, 1, At, B1); PG8_BAR; PG8_SCHED;
            PG8_LDB(B0, 1, 0); PG8_LDB(B1, 1, 1); PG8_SCHED; PG8_LDA(At, 1, 0); PG8_STAGE(PG8_SA(0, 1), a2 + hstepA, voffA);
            PG8_WAIT_V(8); PG8_WAIT_L(0); PG8_BAR; PG8_MMA(0, 0, At, B0); PG8_MMA(0, 1, At, B1); PG8_BAR; PG8_SCHED;
            PG8_LDA(At, 1, 1); PG8_STAGE(PG8_SB(1, 0), b3, voffB); PG8_STAGE(PG8_SB(1, 1), b3 + hstepB, voffB); PG8_STAGE(PG8_SA(1, 0), a3, voffA);
            PG8_WAIT_V(8); PG8_WAIT_L(0); PG8_BAR; PG8_MMA(1, 0, At, B0); PG8_MMA(1, 1, At, B1); PG8_BAR; PG8_SCHED;
            } else {
            PG8_LDB(B0, 0, 0); PG8_SCHED; PG8_LDA(At, 0, 0); PG8_STAGE(PG8_SA(1, 1), a1 + hstepA, voffA);
            PG8_WAIT_L(8); PG8_BAR; PG8_WAIT_L(0); PG8_MMA(0, 0, At, B0); PG8_BAR; PG8_SCHED;
            PG8_LDB(B1, 0, 1); PG8_STAGE(PG8_SB(0, 0), b2, voffB);
            PG8_BAR; PG8_WAIT_L(0); PG8_MMA(0, 1, At, B1); PG8_BAR;
            PG8_LDA(At, 0, 1); PG8_STAGE(PG8_SA(0, 0), a2, voffA);
            PG8_BAR; PG8_WAIT_L(0); PG8_MMA(1, 0, At, B0); PG8_BAR; PG8_SCHED;
            PG8_STAGE(PG8_SB(0, 1), b2 + hstepB, voffB);
            PG8_WAIT_V(6); PG8_BAR; PG8_MMA(1, 1, At, B1); PG8_BAR;
            PG8_LDB(B0, 1, 0); PG8_SCHED; PG8_LDA(At, 1, 0); PG8_STAGE(PG8_SA(0, 1), a2 + hstepA, voffA);
            PG8_WAIT_L(8); PG8_BAR; PG8_WAIT_L(0); PG8_MMA(0, 0, At, B0); PG8_BAR; PG8_SCHED;
            PG8_LDB(B1, 1, 1); PG8_STAGE(PG8_SB(1, 0), b3, voffB);
            PG8_BAR; PG8_WAIT_L(0); PG8_MMA(0, 1, At, B1); PG8_BAR;
            PG8_LDA(At, 1, 1); PG8_STAGE(PG8_SA(1, 0), a3, voffA);
            PG8_BAR; PG8_WAIT_L(0); PG8_MMA(1, 0, At, B0); PG8_BAR; PG8_SCHED;
            PG8_STAGE(PG8_SB(1, 1), b3 + hstepB, voffB);
            PG8_WAIT_V(6); PG8_BAR; PG8_MMA(1, 1, At, B1); PG8_BAR;
            }
        }
        if constexpr (ALIGN_EPI) { if (wr == 0) PG8_BAR; }
        if constexpr (!Epi::AFTER_DRAIN) { E(acc, cur, wr, wc, fr, fq); S.done(cur); }
        if (!has_next) break;
#pragma unroll
        for (int a = 0; a < 2; ++a)
#pragma unroll
            for (int b = 0; b < 2; ++b)
#pragma unroll
                for (int m = 0; m < 4; ++m)
#pragma unroll
                    for (int n = 0; n < 2; ++n) acc[a][b][m][n] = (f32x4){0.f, 0.f, 0.f, 0.f};
        cur = nxt; cA = nA; cB = nB; ++ui;
        if constexpr (ALIGN_EPI) { if (wr == 1) PG8_BAR; }
    }
    PG8_WAIT_V(0);
    if constexpr (!ALIGN_EPI) { if (wr == 0) PG8_BAR; }
    PG8_BAR;
    if constexpr (Epi::AFTER_DRAIN) { E.fused(acc, cur, wr, wc, fr, fq, lds, wid, lane); S.done(cur); }
#undef PG8_SA
#undef PG8_SB
#undef PG8_STAGE
#undef PG8_LDA
#undef PG8_LDB
#undef PG8_MMA
#undef PG8_WAIT_V
#undef PG8_WAIT_L
#undef PG8_BAR
#undef PG8_SCHED
}
}

typedef unsigned short bf16_t;
constexpr int DM = 2048, NB = 2, SEQ = 4096, MTOK = NB * SEQ;
constexpr int SGW_ = 1024, QW = 1024, KVW = 256, INW = 7680, DFF = 5632, UPW = 2 * DFF;
constexpr float EPS = 1e-6f;
constexpr float LOG2E = 1.4426950408889634f;
constexpr float QSCALE = 0.08838834764831845f * 1.4426950408889634f;
constexpr size_t MiB = 1u << 20;
constexpr size_t WS_CTL = 0;
constexpr size_t WS_ROPE = 1 * MiB;
constexpr size_t WS_WIN = 4 * MiB, WS_WAB = 34 * MiB, WS_WO = 42 * MiB, WS_WUP = 50 * MiB, WS_WDN = 94 * MiB;
constexpr size_t WS_XN = 117 * MiB;
constexpr size_t WS_GU = 117 * MiB, WS_VN = 133 * MiB, WS_MG = 117 * MiB, WS_H = 117 * MiB;
constexpr size_t WS_Q = 4 * MiB, WS_K = 20 * MiB, WS_V = 24 * MiB;
constexpr size_t WS_Z = 149 * MiB;
constexpr size_t WS_AB = 149 * MiB, WS_P1 = 181 * MiB, WS_Y = 149 * MiB;
constexpr size_t WS_RA = 269 * MiB, WS_SB = 301 * MiB;
constexpr size_t WS_HF = 213 * MiB;
constexpr size_t WS_U = 246 * MiB, WS_F = 246 * MiB;
constexpr size_t WS_END = 334 * MiB;

#define DEV __device__ __forceinline__
DEV float bf2f(bf16_t v) { return __uint_as_float(((unsigned)v) << 16); }
DEV bf16_t f2bf(float f) { unsigned u = __float_as_uint(f); return (bf16_t)((u + 0x7fffu + ((u >> 16) & 1u)) >> 16); }
DEV unsigned pk2(float lo, float hi) { return (unsigned)f2bf(lo) | ((unsigned)f2bf(hi) << 16); }
DEV float gelu_tanh(float x) { const float u = 0.7978845608028654f * (x + 0.044715f * x * x * x); return x / (1.f + __expf(-2.f * u)); }
DEV float sigmoid_f(float g) { return 1.f / (1.f + __expf(-g)); }
DEV float wave_sum(float v) {
#pragma unroll
    for (int o = 1; o < 64; o <<= 1) v += __shfl_xor(v, o);
    return v;
}
DEV int colmap(int mode, int n) {
    if (mode == 1) { if (n < 3584) return n; const int j = (n - 3584) >> 8, c = (n - 3584) & 255; return c < 128 ? 3584 + 128 * j + c : 3584 + 2048 + 128 * j + (c - 128); }
    if (mode == 2) { const int j = n >> 8, c = n & 255; return c < 128 ? 128 * j + c : DFF + 128 * j + (c - 128); }
    return n;
}
#define LAS __attribute__((address_space(3)))
#define XB_TMO      128
#define XB_XCNT(j)  (256  + 64 * (j))
#define XB_XSUB(j)  (1280 + 64 * (j))
#define XB_XGEN(j)  (2304 + 64 * (j))
#define XB_TOP      3328
#define XB_TOPGEN   3392
#define XCD_BAR_WORDS 3456
#define XB_SPIN_CAP (1u << 18)

__device__ __forceinline__ unsigned xb_ld(unsigned* p)              { return __hip_atomic_load(p, __ATOMIC_RELAXED, __HIP_MEMORY_SCOPE_AGENT); }
__device__ __forceinline__ unsigned xb_add(unsigned* p, unsigned v) { return __hip_atomic_fetch_add(p, v, __ATOMIC_RELAXED, __HIP_MEMORY_SCOPE_AGENT); }
__device__ __forceinline__ unsigned xb_xcc_id() { return (unsigned)__builtin_amdgcn_s_getreg((3 << 11) | 20) & 0xFu; }
#define XB_SPIN(cond, bar) do { unsigned _sp = 0; while (cond) { __builtin_amdgcn_s_sleep(1); \
    if ((++_sp & 255u) == 0u) { if (xb_ld(&(bar)[XB_TMO])) break; if (_sp > XB_SPIN_CAP) { atomicAdd(&(bar)[XB_TMO], 1u); break; } } } } while (0)

struct XcdBarrier {
    unsigned* bar; unsigned x;
    volatile LAS unsigned* st;
};

__device__ __forceinline__ XcdBarrier xcd_barrier_post(unsigned* bar, volatile LAS unsigned* st) {
    XcdBarrier b; b.bar = bar; b.x = xb_xcc_id(); b.st = st;
    if (threadIdx.x == 0) (void)xb_add(&bar[XB_XCNT(b.x)], 1u);
    return b;
}
__device__ __forceinline__ void xcd_barrier_complete(unsigned* bar, unsigned x, unsigned& nloc, unsigned& nx) {
    const unsigned G = gridDim.x * gridDim.y * gridDim.z;
    unsigned sum, cnt, mine, sp = 0u;
    for (;;) {
        sum = 0u; cnt = 0u; mine = 0u;
#pragma unroll
        for (unsigned j = 0; j < 16; ++j) { const unsigned c = xb_ld(&bar[XB_XCNT(j)]); sum += c; cnt += (c > 0u) ? 1u : 0u; mine = (j == x) ? c : mine; }
        if (sum == G) break;
        __builtin_amdgcn_s_sleep(1);
        if ((++sp & 255u) == 0u) { if (xb_ld(&bar[XB_TMO])) break; if (sp > XB_SPIN_CAP) { atomicAdd(&bar[XB_TMO], 1u); break; } }
    }
    nloc = mine > 0u ? mine : 1u; nx = cnt > 0u ? cnt : 1u;
}

__device__ __forceinline__ void xcd_barrier(const XcdBarrier& b) {
    asm volatile("s_waitcnt vmcnt(0)" ::: "memory");
    __syncthreads();
    if (threadIdx.x == 0) {
        unsigned* bar = b.bar;
        __builtin_amdgcn_s_waitcnt(0);
        unsigned nloc = b.st[0], nx = b.st[1];
        if (nloc == 0u) { xcd_barrier_complete(bar, b.x, nloc, nx); b.st[0] = nloc; b.st[1] = nx; }
        const unsigned old = xb_add(&bar[XB_XSUB(b.x)], 1u);
        const unsigned gen = old / nloc;
        if (old + 1u == (gen + 1u) * nloc) {
            __builtin_amdgcn_fence(__ATOMIC_RELEASE, "agent");
            asm volatile("s_waitcnt vmcnt(0)" ::: "memory");
            const unsigned og = xb_add(&bar[XB_TOP], 1u);
            const unsigned tg = og / nx;
            if (og + 1u == (tg + 1u) * nx) xb_add(&bar[XB_TOPGEN], 1u);
            else XB_SPIN(xb_ld(&bar[XB_TOPGEN]) == tg, bar);
            __builtin_amdgcn_fence(__ATOMIC_ACQUIRE, "agent");
            xb_add(&bar[XB_XGEN(b.x)], 1u);
            asm volatile("s_waitcnt vmcnt(0)" ::: "memory");
        } else {
            XB_SPIN(xb_ld(&bar[XB_XGEN(b.x)]) == gen, bar);
            __builtin_amdgcn_fence(__ATOMIC_ACQUIRE, "agent");
            asm volatile("s_waitcnt vmcnt(0)" ::: "memory");
        }
    }
    __syncthreads();
}
constexpr int NWAVES = 8;
constexpr int RING_BYTES = 131072, LDSCTL_OFF = RING_BYTES, MISC_OFF = LDSCTL_OFF + 320, LDS_BYTES = 147456;
constexpr int CW_BAR = 4096;
constexpr size_t CTL_ZERO_BYTES = 65536;
struct Ctx { int lane, wave, tid, gw, NGW, gtid, NGT; unsigned char* lds; };

DEV void p_transpose(const Ctx& c, const float* __restrict__ W, bf16_t* WT, int K, int N, int ndst, int ldk, int koff, int mode) {
    float* scr = (float*)(c.lds + c.wave * (64 * 33 * 4)); const int lane = c.lane;
    const int nblk = ndst / 32, nitems = (K / 64) * nblk;
    for (int item = c.gw; item < nitems; item += c.NGW) {
        const int kb = item / nblk, nb = item % nblk, k0 = 64 * kb, n0 = 32 * nb, s0 = colmap(mode, n0);
#pragma unroll 8
        for (int i = 0; i < 32; ++i) { const int kk = 2 * i + (lane >> 5); scr[kk * 33 + (lane & 31)] = W[(size_t)(k0 + kk) * N + s0 + (lane & 31)]; }
        __builtin_amdgcn_wave_barrier(); asm volatile("s_waitcnt lgkmcnt(0)" ::: "memory");
        const int cc = lane & 7;
#pragma unroll
        for (int j = 0; j < 4; ++j) { const int n = (lane >> 3) + 8 * j; const float* s = scr + (8 * cc) * 33 + n;
            uint4 o; o.x = pk2(s[0 * 33], s[1 * 33]); o.y = pk2(s[2 * 33], s[3 * 33]); o.z = pk2(s[4 * 33], s[5 * 33]); o.w = pk2(s[6 * 33], s[7 * 33]);
            *(uint4*)(WT + (size_t)(n0 + n) * ldk + koff + k0 + 8 * cc) = o; }
        __builtin_amdgcn_wave_barrier(); asm volatile("s_waitcnt lgkmcnt(0)" ::: "memory");
    }
}
DEV void p_rms_in(const Ctx& c, const float* __restrict__ x, const float* __restrict__ g, bf16_t* out) {
    const int lane = c.lane;
    for (int row = c.gw; row < MTOK; row += c.NGW) {
        const float4* xr = (const float4*)(x + (size_t)row * DM); const float4* gr = (const float4*)g;
        float4 v[8]; float ss = 0.f;
#pragma unroll
        for (int j = 0; j < 8; ++j) { v[j] = xr[lane + 64 * j]; ss += v[j].x * v[j].x + v[j].y * v[j].y + v[j].z * v[j].z + v[j].w * v[j].w; }
        const float r = rsqrtf(wave_sum(ss) * (1.f / DM) + EPS);
        uint2* o = (uint2*)(out + (size_t)row * DM);
#pragma unroll
        for (int j = 0; j < 8; ++j) { const float4 gg = gr[lane + 64 * j]; uint2 w; w.x = pk2(v[j].x * r * gg.x, v[j].y * r * gg.y); w.y = pk2(v[j].z * r * gg.z, v[j].w * r * gg.w); o[lane + 64 * j] = w; }
    }
}
__device__ const float INV_FREQ[16] = {1.000000000e+00f, 4.403665960e-01f, 1.939227432e-01f, 8.539710194e-02f, 3.760603070e-02f, 1.656043902e-02f, 7.292664610e-03f, 3.211445874e-03f,
                                       1.414213562e-03f, 6.227723788e-04f, 2.742481884e-04f, 1.207697351e-04f, 5.318296098e-05f, 2.341999971e-05f, 1.031338616e-05f, 4.541670478e-06f};
DEV void p_rope_table(const Ctx& c, float* cosT, float* sinT) {
    for (int idx = c.gtid; idx < SEQ * 16; idx += c.NGT) { const int pos = idx >> 4, i = idx & 15; const float ang = (float)pos * INV_FREQ[i];
        cosT[idx] = (float)cos((double)ang); sinT[idx] = (float)sin((double)ang); }
}
DEV void p_post1(const Ctx& c, const bf16_t* Z, const float* __restrict__ ln_g, const float* __restrict__ ln_b, const float* cosT, const float* sinT,
                 bf16_t* GU, bf16_t* VN, bf16_t* Q, bf16_t* Kb, bf16_t* Vb, bf16_t* RA, bf16_t* SB) {
    const int lane = c.lane;
    for (int row = c.gw; row < MTOK; row += c.NGW) {
        const int pos = row % SEQ; const bf16_t* z = Z + (size_t)row * INW;
        for (int cc = lane; cc < 1024; cc += 64) GU[(size_t)row * 1024 + cc] = f2bf(gelu_tanh(bf2f(z[cc])));
        float gv[16]; float s = 0.f;
#pragma unroll
        for (int j = 0; j < 16; ++j) { gv[j] = gelu_tanh(bf2f(z[1024 + lane + 64 * j])); s += gv[j]; }
        const float mean = wave_sum(s) * (1.f / 1024.f); float q = 0.f;
#pragma unroll
        for (int j = 0; j < 16; ++j) { const float d = gv[j] - mean; q += d * d; }
        const float rstd = rsqrtf(wave_sum(q) * (1.f / 1024.f) + EPS);
#pragma unroll
        for (int j = 0; j < 16; ++j) { const int cc = lane + 64 * j; VN[(size_t)row * 1024 + cc] = f2bf((gv[j] - mean) * rstd * ln_g[cc] + ln_b[cc]); }
        for (int c0 = lane; c0 < 1024 + 256; c0 += 64) {
            const bool isq = c0 < 1024; const int cc = isq ? c0 : c0 - 1024, base = isq ? 2048 : 3072, d = cc & 127, hb = base + (cc & ~127); float val;
            if (d < 32) { const int i = d & 15; const float x1 = bf2f(z[hb + i]), x2 = bf2f(z[hb + 16 + i]), cs = cosT[pos * 16 + i], sn = sinT[pos * 16 + i]; val = d < 16 ? x1 * cs - x2 * sn : x2 * cs + x1 * sn; }
            else val = bf2f(z[hb + d]);
            if (isq) Q[(size_t)row * 1024 + cc] = f2bf(val * QSCALE); else Kb[(size_t)row * 256 + cc] = f2bf(val);
        }
        for (int cc = lane; cc < 256; cc += 64) Vb[(size_t)row * 256 + cc] = z[3328 + cc];
        for (int cc = lane; cc < 2048; cc += 64) { const int j = cc >> 7, i = cc & 127; const float gA = bf2f(z[3584 + 256 * j + i]), gB = bf2f(z[3584 + 256 * j + 128 + i]);
            const float sA = sigmoid_f(gA), sB = sigmoid_f(gB); RA[(size_t)row * 2048 + cc] = f2bf(sA / sB); SB[(size_t)row * 2048 + cc] = f2bf(sB); }
    }
}
DEV void p_sg_naive(const Ctx& c, const bf16_t* GU, const bf16_t* VN, const float* __restrict__ sgw, const float* __restrict__ sgb, bf16_t* AB) {
    for (int idx = c.gtid; idx < MTOK * 1024; idx += c.NGT) {
        const int col = idx & 1023, row = idx >> 10, g = col >> 7, t = row & 127, cb = row - t;
        const float* w = sgw + (size_t)(g * 128 + t) * 128; float acc = 0.f;
        for (int s = 0; s < 128; ++s) acc += w[s] * bf2f(VN[(size_t)(cb + s) * 1024 + col]);
        acc += sgb[g * 128 + t];
        AB[(size_t)row * 2048 + col] = f2bf(bf2f(GU[(size_t)row * 1024 + col]) * acc);
    }
}
DEV void p_attn_naive(const Ctx& c, const bf16_t* Q, const bf16_t* Kb, const bf16_t* Vb, const float* __restrict__ sink, bf16_t* AB) {
    const int lane = c.lane;
    for (int idx = c.gw; idx < MTOK * 8; idx += c.NGW) {
        const int row = idx >> 3, h = idx & 7, kvh = h >> 2, b = row / SEQ, pos = row % SEQ;
        const unsigned qq = *(const unsigned*)(Q + (size_t)row * 1024 + h * 128 + 2 * lane); const float q0 = __uint_as_float(qq << 16), q1 = __uint_as_float(qq & 0xffff0000u);
        float m = sink[h] * LOG2E, l = 1.f, o0 = 0.f, o1 = 0.f;
        const int klo = pos - 128 < 0 ? 0 : pos - 128, khi = pos + 128 > SEQ - 1 ? SEQ - 1 : pos + 128;
        for (int kp = klo; kp <= khi; ++kp) { const size_t kr = (size_t)(b * SEQ + kp) * 256 + kvh * 128 + 2 * lane;
            const unsigned kk = *(const unsigned*)(Kb + kr), vv = *(const unsigned*)(Vb + kr);
            const float s = wave_sum(q0 * __uint_as_float(kk << 16) + q1 * __uint_as_float(kk & 0xffff0000u));
            const float mn = fmaxf(m, s), a = exp2f(m - mn), p = exp2f(s - mn);
            l = l * a + p; o0 = o0 * a + p * __uint_as_float(vv << 16); o1 = o1 * a + p * __uint_as_float(vv & 0xffff0000u); m = mn; }
        const float il = 1.f / l;
        *(unsigned*)(AB + (size_t)row * 2048 + 1024 + h * 128 + 2 * lane) = pk2(o0 * il, o1 * il);
    }
}
DEV void p_post4(const Ctx& c, const float* Y, const float* __restrict__ x, const float* __restrict__ g1, const float* __restrict__ g2, float* out, bf16_t* HF) {
    const int lane = c.lane;
    for (int row = c.gw; row < MTOK; row += c.NGW) {
        const float4* yr = (const float4*)(Y + (size_t)row * DM); const float4* xr = (const float4*)(x + (size_t)row * DM);
        float4 v[8]; float ss = 0.f;
#pragma unroll
        for (int j = 0; j < 8; ++j) { v[j] = yr[lane + 64 * j]; ss += v[j].x * v[j].x + v[j].y * v[j].y + v[j].z * v[j].z + v[j].w * v[j].w; }
        const float r1 = rsqrtf(wave_sum(ss) * (1.f / DM) + EPS); float s2 = 0.f;
#pragma unroll
        for (int j = 0; j < 8; ++j) { const float4 gg = ((const float4*)g1)[lane + 64 * j], xx = xr[lane + 64 * j];
            v[j].x = xx.x + v[j].x * r1 * gg.x; v[j].y = xx.y + v[j].y * r1 * gg.y; v[j].z = xx.z + v[j].z * r1 * gg.z; v[j].w = xx.w + v[j].w * r1 * gg.w;
            s2 += v[j].x * v[j].x + v[j].y * v[j].y + v[j].z * v[j].z + v[j].w * v[j].w; ((float4*)(out + (size_t)row * DM))[lane + 64 * j] = v[j]; }
        const float r2 = rsqrtf(wave_sum(s2) * (1.f / DM) + EPS);
#pragma unroll
        for (int j = 0; j < 8; ++j) { const float4 gg = ((const float4*)g2)[lane + 64 * j]; uint2 w; w.x = pk2(v[j].x * r2 * gg.x, v[j].y * r2 * gg.y); w.y = pk2(v[j].z * r2 * gg.z, v[j].w * r2 * gg.w);
            ((uint2*)(HF + (size_t)row * DM))[lane + 64 * j] = w; }
    }
}
DEV void p_conv_naive(const Ctx& c, const bf16_t* U, const float* __restrict__ cw, const float* __restrict__ cb, bf16_t* H) {
    for (int idx = c.gtid; idx < SEQ * DFF; idx += c.NGT) {
        const int cc = idx % DFF, t = idx / DFF, j = cc >> 7, ci = cc & 127, gcol = 256 * j + ci, vcol = gcol + 128, og = cc, ov = DFF + cc;
        float cg = cb[og], cv = cb[ov];
#pragma unroll
        for (int jj = 0; jj < 3; ++jj) { const int tt = t + jj - 1; if (tt >= 0 && tt < SEQ) { cg += cw[jj * UPW + og] * bf2f(U[(size_t)tt * UPW + gcol]); cv += cw[jj * UPW + ov] * bf2f(U[(size_t)tt * UPW + vcol]); } }
        H[(size_t)t * DFF + cc] = f2bf(gelu_tanh(cg) * cv);
    }
}
DEV void p_post6(const Ctx& c, const float* F, const float* __restrict__ g, float* out) {
    const int lane = c.lane;
    for (int row = c.gw; row < MTOK; row += c.NGW) {
        const float4* fr = (const float4*)(F + (size_t)row * DM); float4* orow = (float4*)(out + (size_t)row * DM);
        float4 v[8]; float ss = 0.f;
#pragma unroll
        for (int j = 0; j < 8; ++j) { v[j] = fr[lane + 64 * j]; ss += v[j].x * v[j].x + v[j].y * v[j].y + v[j].z * v[j].z + v[j].w * v[j].w; }
        const float r = rsqrtf(wave_sum(ss) * (1.f / DM) + EPS);
#pragma unroll
        for (int j = 0; j < 8; ++j) { const float4 gg = ((const float4*)g)[lane + 64 * j]; float4 xx = orow[lane + 64 * j];
            xx.x += v[j].x * r * gg.x; xx.y += v[j].y * r * gg.y; xx.z += v[j].z * r * gg.z; xx.w += v[j].w * r * gg.w; orow[lane + 64 * j] = xx; }
    }
}

struct Params { const float* in[18]; float* out; unsigned char* ws; };
__global__ void __launch_bounds__(NWAVES * 64, 2) mk_fwd(Params p) {
    extern __shared__ __attribute__((aligned(16))) unsigned char lds[];
    const int G = gridDim.x;
    LAS unsigned char* ldsl = (LAS unsigned char*)lds;
    for (int u = threadIdx.x; u < (LDS_BYTES - LDSCTL_OFF) / 4; u += NWAVES * 64) ((LAS unsigned*)(ldsl + LDSCTL_OFF))[u] = 0u;
    __syncthreads();
    XcdBarrier bar = xcd_barrier_post((unsigned*)(p.ws + WS_CTL) + CW_BAR, (volatile LAS unsigned*)(ldsl + MISC_OFF) + 8);
#define MKCTX() Ctx c; { int t_ = threadIdx.x; asm volatile("" : "+v"(t_)); c.tid = t_; c.lane = t_ & 63; c.wave = __builtin_amdgcn_readfirstlane(t_ >> 6); \
        c.gw = blockIdx.x * NWAVES + c.wave; c.NGW = G * NWAVES; c.gtid = blockIdx.x * (NWAVES * 64) + t_; c.NGT = G * NWAVES * 64; c.lds = lds; }
#define WSP(T, off) ((T*)(p.ws + (off)))
#define x_in p.in[0]
#define norm_mix_pre p.in[1]
#define w_in p.in[2]
#define sg_ln_g p.in[3]
#define sg_ln_b p.in[4]
#define sg_w p.in[5]
#define sg_b p.in[6]
#define attn_sink p.in[7]
#define w_a p.in[8]
#define w_b p.in[9]
#define w_out p.in[10]
#define norm_mix_post p.in[11]
#define norm_ffn_pre p.in[12]
#define w_up p.in[13]
#define conv_w p.in[14]
#define conv_b p.in[15]
#define w_down p.in[16]
#define norm_ffn_post p.in[17]
#define out_f p.out
#define WinT WSP(bf16_t, WS_WIN)
#define WabT WSP(bf16_t, WS_WAB)
#define WoT WSP(bf16_t, WS_WO)
#define WupT WSP(bf16_t, WS_WUP)
#define WdT WSP(bf16_t, WS_WDN)
#define XN WSP(bf16_t, WS_XN)
#define Z WSP(bf16_t, WS_Z)
#define GU WSP(bf16_t, WS_GU)
#define VN WSP(bf16_t, WS_VN)
#define Q WSP(bf16_t, WS_Q)
#define Kb WSP(bf16_t, WS_K)
#define Vb WSP(bf16_t, WS_V)
#define RA WSP(bf16_t, WS_RA)
#define SB WSP(bf16_t, WS_SB)
#define AB WSP(bf16_t, WS_AB)
#define P1 WSP(float, WS_P1)
#define MG WSP(bf16_t, WS_MG)
#define Y WSP(float, WS_Y)
#define HF WSP(bf16_t, WS_HF)
#define U WSP(bf16_t, WS_U)
#define H WSP(bf16_t, WS_H)
#define F WSP(float, WS_F)
#define cosT WSP(float, WS_ROPE)
#define sinT (WSP(float, WS_ROPE) + SEQ * 16)
#define GRID_BAR() xcd_barrier(bar)
#define GEMM(EPI, ...) pg8::gemm_phase<EPI, pg8::StaticOrder, true, true>(ldsl, __VA_ARGS__)
    { MKCTX();
    p_transpose(c, w_in, WinT, DM, INW, INW, DM, 0, 1);
    p_transpose(c, w_a, WabT, 1024, DM, DM, 2048, 0, 0);
    p_transpose(c, w_b, WabT, 1024, DM, DM, 2048, 1024, 0);
    p_transpose(c, w_out, WoT, DM, DM, DM, DM, 0, 0);
    p_transpose(c, w_up, WupT, DM, UPW, UPW, DM, 0, 2);
    p_transpose(c, w_down, WdT, DFF, DM, DM, DFF, 0, 0);
    p_rms_in(c, x_in, norm_mix_pre, XN);
    p_rope_table(c, cosT, sinT); }
    GRID_BAR();
    { pg8::Gemm g{XN, WinT, MTOK, INW, DM, DM, DM, 0}; pg8::StaticOrder S; S.init(g.M, g.N, G, (int)blockIdx.x); pg8::EpiBf16Plain E{Z, INW, 0}; GEMM(pg8::EpiBf16Plain, g, S, E); }
    GRID_BAR();
    { MKCTX(); p_post1(c, Z, sg_ln_g, sg_ln_b, cosT, sinT, GU, VN, Q, Kb, Vb, RA, SB); }
    GRID_BAR();
    { MKCTX(); p_sg_naive(c, GU, VN, sg_w, sg_b, AB); p_attn_naive(c, Q, Kb, Vb, attn_sink, AB); }
    GRID_BAR();
    { pg8::Gemm g{AB, WabT, MTOK, DM, 1024, 2048, 2048, 0}; pg8::StaticOrder S; S.init(g.M, g.N, G, (int)blockIdx.x); pg8::EpiF32 E{P1, RA, DM, DM}; GEMM(pg8::EpiF32, g, S, E); }
    GRID_BAR();
    { pg8::Gemm g{AB + 1024, WabT + 1024, MTOK, DM, 1024, 2048, 2048, 0}; pg8::StaticOrder S; S.init(g.M, g.N, G, (int)blockIdx.x); pg8::EpiMerge E{MG, P1, SB, DM, 0}; GEMM(pg8::EpiMerge, g, S, E); }
    GRID_BAR();
    { pg8::Gemm g{MG, WoT, MTOK, DM, DM, DM, DM, 0}; pg8::StaticOrder S; S.init(g.M, g.N, G, (int)blockIdx.x); pg8::EpiF32 E{Y, nullptr, DM, 0}; GEMM(pg8::EpiF32, g, S, E); }
    GRID_BAR();
    { MKCTX(); p_post4(c, Y, x_in, norm_mix_post, norm_ffn_pre, out_f, HF); }
    GRID_BAR();
    for (int b = 0; b < NB; ++b) {
        { pg8::Gemm g{HF + (size_t)b * SEQ * DM, WupT, SEQ, UPW, DM, DM, DM, 0}; pg8::StaticOrder S; S.init(g.M, g.N, G, (int)blockIdx.x); pg8::EpiBf16Plain E{U, UPW, 0}; GEMM(pg8::EpiBf16Plain, g, S, E); }
        GRID_BAR();
        { MKCTX(); p_conv_naive(c, U, conv_w, conv_b, H + (size_t)b * SEQ * DFF); }
        GRID_BAR();
    }
    { pg8::Gemm g{H, WdT, MTOK, DM, DFF, DFF, DFF, 0}; pg8::StaticOrder S; S.init(g.M, g.N, G, (int)blockIdx.x); pg8::EpiF32 E{F, nullptr, DM, 0}; GEMM(pg8::EpiF32, g, S, E); }
    GRID_BAR();
    { MKCTX(); p_post6(c, F, norm_ffn_post, out_f); }
#undef x_in
#undef out_f
#undef Z
#undef Q
#undef U
#undef H
#undef F
#undef Y
}

extern "C" void kernel_launch(void* const* d_in, const int* in_sizes, int n_in, void* d_out, int out_size, void* d_ws, size_t ws_size, hipStream_t stream) {
    (void)in_sizes; (void)out_size;
    static int grid = 0;
    if (grid == 0) {
        if (n_in != 18 || ws_size < WS_END) { fprintf(stderr, "kernel_launch: bad inputs / workspace (%d, %zu)\n", n_in, ws_size); grid = -1; return; }
        int dev = 0, cus = 0, per_cu = 0;
        if (hipGetDevice(&dev) != hipSuccess || hipDeviceGetAttribute(&cus, hipDeviceAttributeMultiprocessorCount, dev) != hipSuccess) { grid = -1; return; }
        if (hipFuncSetAttribute((const void*)mk_fwd, hipFuncAttributeMaxDynamicSharedMemorySize, LDS_BYTES) != hipSuccess) { fprintf(stderr, "kernel_launch: hipFuncSetAttribute failed\n"); grid = -1; return; }
        if (hipOccupancyMaxActiveBlocksPerMultiprocessor(&per_cu, (const void*)mk_fwd, NWAVES * 64, LDS_BYTES) != hipSuccess || per_cu < 1) { fprintf(stderr, "kernel_launch: occupancy query says %d blocks/CU\n", per_cu); (void)hipGetLastError(); }
        grid = cus;
    }
    if (grid < 0) return;
    (void)hipMemsetAsync((char*)d_ws + WS_CTL, 0, CTL_ZERO_BYTES, stream);
    Params p{}; for (int i = 0; i < 18; ++i) p.in[i] = (const float*)d_in[i]; p.out = (float*)d_out; p.ws = (unsigned char*)d_ws;
    hipLaunchKernelGGL(mk_fwd, dim3(grid), dim3(NWAVES * 64), LDS_BYTES, stream, p);
}
```

```cpp
#include <hip/hip_runtime.h>
#include <cstdio>
#include <cstdint>
namespace pg8 {
#define PG8_LAS __attribute__((address_space(3)))
typedef unsigned short bf16_t;
typedef short bf16x8 __attribute__((ext_vector_type(8)));
typedef float f32x4 __attribute__((ext_vector_type(4)));
typedef unsigned u32x4 __attribute__((ext_vector_type(4)));
constexpr int BM = 256, BK = 64, HALF = 128, HTB = HALF * BK * 2  , STAGE_BYTES = 8 * HTB, NXCD = 8, WGM = 8;

__host__ __device__ __forceinline__ int lds_byte(int r, int c) { const int st = (r >> 4) * 2 + (c >> 5), rr = r & 15, cc = c & 31, ob = rr * 64 + cc * 2; return st * 1024 + (ob ^ (((ob >> 9) & 1) << 5)); }
__host__ __device__ __forceinline__ void stage_rc(int b, int& R, int& C) { const int st = b / 1024, sb = b % 1024, swz = sb ^ (((sb >> 9) & 1) << 5); R = (st >> 1) * 16 + swz / 64; C = (st & 1) * 32 + (swz % 64) / 2; }
__host__ __device__ __forceinline__ int perm32(int rho) { const int n = rho >> 4, i = rho & 15; return 8 * (i >> 2) + 4 * n + (i & 3); }

struct Unit { int pm, pn; };
struct Gemm { const bf16_t* A; const bf16_t* Bt; int M, N, K, lda, ldb, pad; };

struct StaticOrder {
    int nM, nN, nwg, G, c;
    __host__ __device__ void init(int M, int N, int G_, int c_) { nM = M / BM; nN = N / BM; nwg = nM * nN; G = G_; c = c_; }
    __host__ __device__ bool next(int i, Unit& u) const {
        const long L = (long)i * G + c; if (L >= nwg) return false;
        int wgid = (int)L; { const int q = nwg / NXCD, r = nwg % NXCD, xcd = wgid % NXCD, off = wgid / NXCD; wgid = (xcd < r ? xcd * (q + 1) : r * (q + 1) + (xcd - r) * q) + off; }
        const int nig = WGM * nN, gid = wgid / nig, fm = gid * WGM, gsz = (nM - fm) < WGM ? (nM - fm) : WGM;
        u.pm = fm + ((wgid % nig) % gsz); u.pn = (wgid % nig) / gsz; return true;
    }
    __device__ __forceinline__ void a_ready(const Unit&) const {}
    __device__ __forceinline__ void done(const Unit&) const {}
};


__device__ __forceinline__ unsigned cvt_pk_bf16(float lo, float hi) { unsigned r; asm volatile("v_cvt_pk_bf16_f32 %0, %1, %2" : "=v"(r) : "v"(lo), "v"(hi)); return r; }
typedef unsigned u32x2 __attribute__((ext_vector_type(2)));
__device__ __forceinline__ float gelu_t(float x) { const float u = 0.7978845608028654f * (x + 0.044715f * x * x * x); return x / (1.f + __expf(-2.f * u)); }
struct EpiIn {
    static constexpr bool PERM = true, AFTER_DRAIN = false;
    bf16_t* GU; bf16_t* GV; bf16_t* Q; bf16_t* Kb; bf16_t* Vb; bf16_t* RA; bf16_t* SB; float* stats; const float* cosT; const float* sinT;
    __device__ __forceinline__ static u32x4 pack8(const f32x4 v0, const f32x4 v1) { u32x4 w; w.x = cvt_pk_bf16(v0[0], v0[1]); w.y = cvt_pk_bf16(v0[2], v0[3]); w.z = cvt_pk_bf16(v1[0], v1[1]); w.w = cvt_pk_bf16(v1[2], v1[3]); return w; }
    __device__ __forceinline__ void operator()(const f32x4 (&acc)[2][2][4][2], const Unit& u, int wr, int wc, int fr, int fq) const {
        const int row0 = u.pm * BM + wr * 64 + fr, c8 = wc * 32 + 8 * fq, pn = u.pn;
        if (pn < 8) {
            bf16_t* O = pn < 4 ? GU : GV; const int colt = (pn & 3) * 256 + c8; const bool st = pn >= 4;
#pragma unroll
            for (int ai = 0; ai < 2; ++ai)
#pragma unroll
                for (int m = 0; m < 4; ++m) { const int row = row0 + ai * HALF + m * 16; float s = 0.f, q = 0.f;
#pragma unroll
                    for (int bj = 0; bj < 2; ++bj) { f32x4 v0 = acc[ai][bj][m][0], v1 = acc[ai][bj][m][1];
#pragma unroll
                        for (int k = 0; k < 4; ++k) { v0[k] = gelu_t(v0[k]); v1[k] = gelu_t(v1[k]); s += v0[k] + v1[k]; q += v0[k] * v0[k] + v1[k] * v1[k]; }
                        *(u32x4*)(O + (size_t)row * 1024 + colt + bj * HALF) = pack8(v0, v1); }
                    if (st) { s += __shfl_xor(s, 16); s += __shfl_xor(s, 32); q += __shfl_xor(q, 16); q += __shfl_xor(q, 32);
                        if (fq == 0) { atomicAdd(stats + 2 * row, s); atomicAdd(stats + 2 * row + 1, q); } } }
        } else if (pn < 13) {
            const bool isq = pn < 12; bf16_t* O = isq ? Q + (pn - 8) * 256 : Kb; const int ld = isq ? 1024 : 256; const float sc = isq ? 0.08838834764831845f * 1.4426950408889634f : 1.f;
#pragma unroll
            for (int ai = 0; ai < 2; ++ai)
#pragma unroll
                for (int m = 0; m < 4; ++m) { const int row = row0 + ai * HALF + m * 16, pos = row & 4095;
                    f32x4 cs[2], sn[2];
                    if (wc == 0) { const float* ct = cosT + pos * 16 + 8 * (fq & 1); const float* stp = sinT + pos * 16 + 8 * (fq & 1);
                        cs[0] = *(const f32x4*)ct; cs[1] = *(const f32x4*)(ct + 4); sn[0] = *(const f32x4*)stp; sn[1] = *(const f32x4*)(stp + 4); }
#pragma unroll
                    for (int bj = 0; bj < 2; ++bj) { f32x4 v[2] = {acc[ai][bj][m][0], acc[ai][bj][m][1]};
                        if (wc == 0) {
#pragma unroll
                            for (int n = 0; n < 2; ++n)
#pragma unroll
                                for (int k = 0; k < 4; ++k) { const float own = v[n][k], oth = __shfl_xor(own, 32); v[n][k] = own * cs[n][k] + (fq < 2 ? -oth : oth) * sn[n][k]; } }
                        v[0] = v[0] * sc; v[1] = v[1] * sc;
                        *(u32x4*)(O + (size_t)row * ld + bj * HALF + c8) = pack8(v[0], v[1]); } }
        } else if (pn == 13) {
#pragma unroll
            for (int ai = 0; ai < 2; ++ai)
#pragma unroll
                for (int m = 0; m < 4; ++m) { const int row = row0 + ai * HALF + m * 16;
#pragma unroll
                    for (int bj = 0; bj < 2; ++bj) *(u32x4*)(Vb + (size_t)row * 256 + bj * HALF + c8) = pack8(acc[ai][bj][m][0], acc[ai][bj][m][1]); }
        } else {
            const int col = (pn - 14) * 128 + c8;
#pragma unroll
            for (int ai = 0; ai < 2; ++ai)
#pragma unroll
                for (int m = 0; m < 4; ++m) { const int row = row0 + ai * HALF + m * 16; f32x4 ra[2], sb[2];
#pragma unroll
                    for (int n = 0; n < 2; ++n)
#pragma unroll
                        for (int k = 0; k < 4; ++k) { const float gA = fminf(fmaxf(acc[ai][0][m][n][k], -30.f), 30.f), gB = fminf(fmaxf(acc[ai][1][m][n][k], -30.f), 30.f);
                            const float eA = __expf(-gA), eB = __expf(-gB); ra[n][k] = (1.f + eB) / (1.f + eA); sb[n][k] = 1.f / (1.f + eB); }
                    *(u32x4*)(RA + (size_t)row * 2048 + col) = pack8(ra[0], ra[1]); *(u32x4*)(SB + (size_t)row * 2048 + col) = pack8(sb[0], sb[1]); }
        }
    }
};


struct EpiBf16Plain {
    static constexpr bool PERM = true, AFTER_DRAIN = false;
    bf16_t* O; int ldc, pad;
    __device__ __forceinline__ void operator()(const f32x4 (&acc)[2][2][4][2], const Unit& u, int wr, int wc, int fr, int fq) const {
        const int row0 = u.pm * BM + wr * 64 + fr, col0 = u.pn * BM + wc * 32 + 8 * fq;
#pragma unroll
        for (int ai = 0; ai < 2; ++ai)
#pragma unroll
            for (int m = 0; m < 4; ++m) { bf16_t* rowp = O + (size_t)(row0 + ai * HALF + m * 16) * ldc + col0;
#pragma unroll
                for (int bj = 0; bj < 2; ++bj) { const f32x4 v0 = acc[ai][bj][m][0], v1 = acc[ai][bj][m][1];
                    u32x4 w; w.x = cvt_pk_bf16(v0[0], v0[1]); w.y = cvt_pk_bf16(v0[2], v0[3]); w.z = cvt_pk_bf16(v1[0], v1[1]); w.w = cvt_pk_bf16(v1[2], v1[3]);
                    *(u32x4*)(rowp + bj * HALF) = w; } }
    }
};
__device__ __forceinline__ float bfbits2f(unsigned short v) { return __uint_as_float(((unsigned)v) << 16); }
struct EpiF32 {
    static constexpr bool PERM = false, AFTER_DRAIN = false;
    float* O; const bf16_t* S; int ldc, lds_;
    __device__ __forceinline__ void operator()(const f32x4 (&acc)[2][2][4][2], const Unit& u, int wr, int wc, int fr, int fq) const {
        const int row0 = u.pm * BM + wr * 64 + fr, col0 = u.pn * BM + wc * 32 + 4 * fq;
#pragma unroll
        for (int ai = 0; ai < 2; ++ai)
#pragma unroll
            for (int m = 0; m < 4; ++m) { const size_t r = (size_t)(row0 + ai * HALF + m * 16);
#pragma unroll
                for (int bj = 0; bj < 2; ++bj)
#pragma unroll
                    for (int n = 0; n < 2; ++n) { f32x4 v = acc[ai][bj][m][n]; const int c = col0 + bj * HALF + n * 16;
                        if (S) { const u32x2 s = *(const u32x2*)(S + r * lds_ + c);
                            v[0] *= __uint_as_float(s.x << 16); v[1] *= __uint_as_float(s.x & 0xffff0000u); v[2] *= __uint_as_float(s.y << 16); v[3] *= __uint_as_float(s.y & 0xffff0000u); }
                        *(f32x4*)(O + r * ldc + c) = v; } }
    }
};
struct EpiMerge {
    static constexpr bool PERM = false, AFTER_DRAIN = false;
    bf16_t* O; const float* P; const bf16_t* S; int ldc, pad;
    __device__ __forceinline__ void operator()(const f32x4 (&acc)[2][2][4][2], const Unit& u, int wr, int wc, int fr, int fq) const {
        const int row0 = u.pm * BM + wr * 64 + fr, col0 = u.pn * BM + wc * 32 + 4 * fq;
#pragma unroll
        for (int ai = 0; ai < 2; ++ai)
#pragma unroll
            for (int m = 0; m < 4; ++m) { const size_t r = (size_t)(row0 + ai * HALF + m * 16);
#pragma unroll
                for (int bj = 0; bj < 2; ++bj)
#pragma unroll
                    for (int n = 0; n < 2; ++n) { const int c = col0 + bj * HALF + n * 16; f32x4 v = acc[ai][bj][m][n] + *(const f32x4*)(P + r * ldc + c);
                        const u32x2 s = *(const u32x2*)(S + r * ldc + c);
                        v[0] *= __uint_as_float(s.x << 16); v[1] *= __uint_as_float(s.x & 0xffff0000u); v[2] *= __uint_as_float(s.y << 16); v[3] *= __uint_as_float(s.y & 0xffff0000u);
                        u32x2 w; w.x = cvt_pk_bf16(v[0], v[1]); w.y = cvt_pk_bf16(v[2], v[3]); *(u32x2*)(O + r * ldc + c) = w; } }
    }
};

template <class Epi, class Sched, bool ALIGN_EPI = false, bool SP2 = false>
__device__ __forceinline__ void gemm_phase(PG8_LAS unsigned char* lds, const Gemm g, const Sched& S, const Epi& E) {
    int tid_ = threadIdx.x; asm volatile("" : "+v"(tid_));
    const int tid = tid_, wid = __builtin_amdgcn_readfirstlane(tid >> 6), lane = tid & 63, wr = wid >> 2, wc = wid & 3, fr = lane & 15, fq = lane >> 4;
    const int K = g.K, nt = K / BK;
    unsigned voffA[2], voffB[2];
#pragma unroll
    for (int i = 0; i < 2; ++i) { int R, C; stage_rc(tid * 16 + i * 8192, R, C); const int Rb = Epi::PERM ? ((R & ~31) + perm32(R & 31)) : R;
        voffA[i] = (unsigned)(R * g.lda + C) * 2u; voffB[i] = (unsigned)(Rb * g.ldb + C) * 2u; }
    const size_t kstep = (size_t)(BK * 2);
    const size_t hstepA = (size_t)HALF * g.lda * 2, hstepB = (size_t)HALF * g.ldb * 2;
    const size_t tstepA = 2 * hstepA, tstepB = 2 * hstepB;
    const unsigned ldsw = (unsigned)wid * 1024u;
    const int aoff = lds_byte(wr * 64 + fr, fq * 8), boff = lds_byte(wc * 32 + fr, fq * 8);
#define PG8_SA(b, h) (((b) * 2 + (h)) * HTB)
#define PG8_SB(b, h) ((4 + (b) * 2 + (h)) * HTB)
#define PG8_STAGE(bufoff, gbase, voff) do { _Pragma("unroll") for (int _i = 0; _i < 2; ++_i) \
        __builtin_amdgcn_global_load_lds((const unsigned*)((const char*)(gbase) + (voff)[_i]), (PG8_LAS unsigned*)(lds + (bufoff) + ldsw + _i * 8192), 16, 0, 0); } while (0)
#define PG8_LDA(dst, b, h) do { _Pragma("unroll") for (int m = 0; m < 4; ++m) _Pragma("unroll") for (int k = 0; k < 2; ++k) dst[m][k] = *(const PG8_LAS bf16x8*)(lds + PG8_SA(b, h) + aoff + m * 2048 + k * 1024); } while (0)
#define PG8_LDB(dst, b, h) do { _Pragma("unroll") for (int n = 0; n < 2; ++n) _Pragma("unroll") for (int k = 0; k < 2; ++k) dst[n][k] = *(const PG8_LAS bf16x8*)(lds + PG8_SB(b, h) + boff + n * 2048 + k * 1024); } while (0)
#define PG8_MMA(ai, bj, At, Bt) do { __builtin_amdgcn_s_setprio(1); _Pragma("unroll") for (int m = 0; m < 4; ++m) _Pragma("unroll") for (int n = 0; n < 2; ++n) _Pragma("unroll") for (int k = 0; k < 2; ++k) \
        acc[ai][bj][m][n] = __builtin_amdgcn_mfma_f32_16x16x32_bf16(Bt[n][k], At[m][k], acc[ai][bj][m][n], 0, 0, 0); __builtin_amdgcn_s_setprio(0); } while (0)
#define PG8_WAIT_V(n) asm volatile("s_waitcnt vmcnt(" #n ")" ::: "memory")
#define PG8_WAIT_L(n) asm volatile("s_waitcnt lgkmcnt(" #n ")" ::: "memory")
#define PG8_BAR __builtin_amdgcn_s_barrier()
#define PG8_SCHED __builtin_amdgcn_sched_barrier(0)
    Unit cur, nxt; int ui = 0;
    if (!S.next(0, cur)) return;
    f32x4 acc[2][2][4][2];
#pragma unroll
    for (int a = 0; a < 2; ++a)
#pragma unroll
        for (int b = 0; b < 2; ++b)
#pragma unroll
            for (int m = 0; m < 4; ++m)
#pragma unroll
                for (int n = 0; n < 2; ++n) acc[a][b][m][n] = (f32x4){0.f, 0.f, 0.f, 0.f};
    bf16x8 At[4][2], B0[2][2], B1[2][2];
    const char* cA = (const char*)g.A + (size_t)cur.pm * tstepA; const char* cB = (const char*)g.Bt + (size_t)cur.pn * tstepB;
    S.a_ready(cur);
    if constexpr (SP2) {
        PG8_STAGE(PG8_SB(0, 0), cB, voffB); PG8_STAGE(PG8_SB(0, 1), cB + hstepB, voffB); PG8_STAGE(PG8_SA(0, 0), cA, voffA); PG8_STAGE(PG8_SA(0, 1), cA + hstepA, voffA);
        if (wr == 1) PG8_BAR;
        PG8_WAIT_V(2); PG8_BAR;
        PG8_STAGE(PG8_SB(1, 0), cB + kstep, voffB); PG8_STAGE(PG8_SA(1, 0), cA + kstep, voffA); PG8_STAGE(PG8_SB(1, 1), cB + hstepB + kstep, voffB);
        PG8_WAIT_V(6); PG8_BAR;
    } else {
        PG8_STAGE(PG8_SB(0, 0), cB, voffB); PG8_STAGE(PG8_SA(0, 0), cA, voffA); PG8_STAGE(PG8_SB(0, 1), cB + hstepB, voffB); PG8_STAGE(PG8_SA(0, 1), cA + hstepA, voffA);
        if (wr == 1) PG8_BAR;
        PG8_WAIT_V(4); PG8_BAR;
        PG8_STAGE(PG8_SB(1, 0), cB + kstep, voffB); PG8_STAGE(PG8_SA(1, 0), cA + kstep, voffA); PG8_STAGE(PG8_SB(1, 1), cB + hstepB + kstep, voffB);
        PG8_WAIT_V(6); PG8_BAR;
    }
    for (;;) {
        const bool has_next = S.next(ui + 1, nxt);
        const char* nA = has_next ? (const char*)g.A + (size_t)nxt.pm * tstepA : cA; const char* nB = has_next ? (const char*)g.Bt + (size_t)nxt.pn * tstepB : cB;
        for (int t = 0; t < nt; t += 2) {
            const bool last = (t == nt - 2);
            const char* a1 = cA + (size_t)(t + 1) * kstep;
            const char* a2 = last ? nA : cA + (size_t)(t + 2) * kstep; const char* b2 = last ? nB : cB + (size_t)(t + 2) * kstep;
            const char* a3 = a2 + kstep; const char* b3 = b2 + kstep;
            if (last && has_next) S.a_ready(nxt);
            if constexpr (SP2) {
            PG8_LDB(B0, 0, 0); PG8_LDB(B1, 0, 1); PG8_SCHED; PG8_LDA(At, 0, 0); PG8_STAGE(PG8_SA(1, 1), a1 + hstepA, voffA);
            PG8_WAIT_V(8); PG8_WAIT_L(0); PG8_BAR; PG8_MMA(0, 0, At, B0); PG8_MMA(0, 1, At, B1); PG8_BAR; PG8_SCHED;
            PG8_LDA(At, 0, 1); PG8_STAGE(PG8_SB(0, 0), b2, voffB); PG8_STAGE(PG8_SB(0, 1), b2 + hstepB, voffB); PG8_STAGE(PG8_SA(0, 0), a2, voffA);
            PG8_WAIT_V(8); PG8_WAIT_L(0); PG8_BAR; PG8_MMA(1, 0, At, B0); PG8_MMA(1, 1, At, B1); PG8_BAR; PG8_SCHED;
            PG8_LDB(B0, 1, 0); PG8_LDB(B1, 1, 1); PG8_SCHED; PG8_LDA(At, 1, 0); PG8_STAGE(PG8_SA(0, 1), a2 + hstepA, voffA);
            PG8_WAIT_V(8); PG8_WAIT_L(0); PG8_BAR; PG8_MMA(0, 0, At, B0); PG8_MMA(0, 1, At, B1); PG8_BAR; PG8_SCHED;
            PG8_LDA(At, 1, 1); PG8_STAGE(PG8_SB(1, 0), b3, voffB); PG8_STAGE(PG8_SB(1, 1), b3 + hstepB, voffB); PG8_STAGE(PG8_SA(1, 0), a3, voffA);
            PG8_WAIT_V(8); PG8_WAIT_L(0); PG8_BAR; PG8_MMA(1, 0, At, B0); PG8_MMA(1, 1, At, B1); PG8_BAR; PG8_SCHED;
            } else {
            PG8_LDB(B0, 0, 0); PG8_SCHED; PG8_LDA(At, 0, 0); PG8_STAGE(PG8_SA(1, 1), a1 + hstepA, voffA);
            PG8_WAIT_L(8); PG8_BAR; PG8_WAIT_L(0); PG8_MMA(0, 0, At, B0); PG8_BAR; PG8_SCHED;
            PG8_LDB(B1, 0, 1); PG8_STAGE(PG8_SB(0, 0), b2, voffB);
            PG8_BAR; PG8_WAIT_L(0); PG8_MMA(0, 1, At, B1); PG8_BAR;
            PG8_LDA(At, 0, 1); PG8_STAGE(PG8_SA(0, 0), a2, voffA);
            PG8_BAR; PG8_WAIT_L(0); PG8_MMA(1, 0, At, B0); PG8_BAR; PG8_SCHED;
            PG8_STAGE(PG8_SB(0, 1), b2 + hstepB, voffB);
            PG8_WAIT_V(6); PG8_BAR; PG8_MMA(1, 1, At, B1); PG8_BAR;
            PG8_LDB(B0, 1, 0); PG8_SCHED; PG8_LDA(At, 1, 0); PG8_STAGE(PG8_SA(0, 1), a2 + hstepA, voffA);
            PG8_WAIT_L(8); PG8_BAR; PG8_WAIT_L(0); PG8_MMA(0, 0, At, B0); PG8_BAR; PG8_SCHED;
            PG8_LDB(B1, 1, 1); PG8_STAGE(PG8_SB(1, 0), b3, voffB);
            PG8_BAR; PG8_WAIT_L(0); PG8_MMA(0, 1, At, B1); PG8_BAR;
            PG8_LDA(At, 1, 1); PG8_STAGE(PG8_SA(1, 0), a3, voffA);
            PG8_BAR; PG8_WAIT_L(0); PG8_MMA(1, 0, At, B0); PG8_BAR; PG8_SCHED;
            PG8_STAGE(PG8_SB(1, 1), b3 + hstepB, voffB);
            PG8_WAIT_V(6); PG8_BAR; PG8_MMA(1, 1, At, B1); PG8_BAR;
            }
        }
        if constexpr (ALIGN_EPI) { if (wr == 0) PG8_BAR; }
        if constexpr (!Epi::AFTER_DRAIN) { E(acc, cur, wr, wc, fr, fq); S.done(cur); }
        if (!has_next) break;
#pragma unroll
        for (int a = 0; a < 2; ++a)
#pragma unroll
            for (int b = 0; b < 2; ++b)
#pragma unroll
                for (int m = 0; m < 4; ++m)
#pragma unroll
                    for (int n = 0; n < 2; ++n) acc[a][b][m][n] = (f32x4){0.f, 0.f, 0.f, 0.f};
        cur = nxt; cA = nA; cB = nB; ++ui;
        if constexpr (ALIGN_EPI) { if (wr == 1) PG8_BAR; }
    }
    PG8_WAIT_V(0);
    if constexpr (!ALIGN_EPI) { if (wr == 0) PG8_BAR; }
    PG8_BAR;
    if constexpr (Epi::AFTER_DRAIN) { E.fused(acc, cur, wr, wc, fr, fq, lds, wid, lane); S.done(cur); }
#undef PG8_SA
#undef PG8_SB
#undef PG8_STAGE
#undef PG8_LDA
#undef PG8_LDB
#undef PG8_MMA
#undef PG8_WAIT_V
#undef PG8_WAIT_L
#undef PG8_BAR
#undef PG8_SCHED
}
}

typedef unsigned short bf16_t;
constexpr int DM = 2048, NB = 2, SEQ = 4096, MTOK = NB * SEQ;
constexpr int SGW_ = 1024, QW = 1024, KVW = 256, INW = 7680, DFF = 5632, UPW = 2 * DFF;
constexpr float EPS = 1e-6f;
constexpr float LOG2E = 1.4426950408889634f;
constexpr float QSCALE = 0.08838834764831845f * 1.4426950408889634f;
constexpr size_t MiB = 1u << 20;
constexpr size_t WS_CTL = 0;
constexpr size_t WS_ROPE = 1 * MiB;
constexpr size_t WS_STATS = 1 * MiB + 512 * 1024;
constexpr size_t WS_XBUF = 2 * MiB;
constexpr size_t WS_WIN = 4 * MiB, WS_WAB = 34 * MiB, WS_WO = 42 * MiB, WS_WUP = 50 * MiB, WS_WDN = 94 * MiB;
constexpr size_t WS_HF = 4 * MiB + 8192;
constexpr size_t WS_XN = 117 * MiB, WS_MG = 117 * MiB;
constexpr size_t WS_GU = 149 * MiB, WS_GV = 165 * MiB, WS_Q = 181 * MiB, WS_K = 197 * MiB, WS_V = 201 * MiB;
constexpr size_t WS_RA = 213 * MiB, WS_SB = 245 * MiB, WS_AB = 277 * MiB;
constexpr size_t WS_P1 = 149 * MiB;
constexpr size_t WS_Y = 213 * MiB;
constexpr size_t WS_H = 117 * MiB;
constexpr size_t WS_U = 205 * MiB, WS_F = 205 * MiB;
constexpr size_t WS_END = 309 * MiB;

#define DEV __device__ __forceinline__
DEV float bf2f(bf16_t v) { return __uint_as_float(((unsigned)v) << 16); }
DEV bf16_t f2bf(float f) { unsigned u = __float_as_uint(f); return (bf16_t)((u + 0x7fffu + ((u >> 16) & 1u)) >> 16); }
DEV unsigned pk2(float lo, float hi) { return (unsigned)f2bf(lo) | ((unsigned)f2bf(hi) << 16); }
DEV float gelu_tanh(float x) { const float u = 0.7978845608028654f * (x + 0.044715f * x * x * x); return x / (1.f + __expf(-2.f * u)); }
DEV float sigmoid_f(float g) { return 1.f / (1.f + __expf(-g)); }
DEV float wave_sum(float v) {
#pragma unroll
    for (int o = 1; o < 64; o <<= 1) v += __shfl_xor(v, o);
    return v;
}
DEV int colmap(int mode, int n) {
    if (mode == 1) { if (n < 3584) return n; const int j = (n - 3584) >> 8, c = (n - 3584) & 255; return c < 128 ? 3584 + 128 * j + c : 3584 + 2048 + 128 * j + (c - 128); }
    if (mode == 2) { const int j = n >> 8, c = n & 255; return c < 128 ? 128 * j + c : DFF + 128 * j + (c - 128); }
    return n;
}
#define LAS __attribute__((address_space(3)))
#define XB_TMO      128
#define XB_XCNT(j)  (256  + 64 * (j))
#define XB_XSUB(j)  (1280 + 64 * (j))
#define XB_XGEN(j)  (2304 + 64 * (j))
#define XB_TOP      3328
#define XB_TOPGEN   3392
#define XCD_BAR_WORDS 3456
#define XB_SPIN_CAP (1u << 18)

__device__ __forceinline__ unsigned xb_ld(unsigned* p)              { return __hip_atomic_load(p, __ATOMIC_RELAXED, __HIP_MEMORY_SCOPE_AGENT); }
__device__ __forceinline__ unsigned xb_add(unsigned* p, unsigned v) { return __hip_atomic_fetch_add(p, v, __ATOMIC_RELAXED, __HIP_MEMORY_SCOPE_AGENT); }
__device__ __forceinline__ unsigned xb_xcc_id() { return (unsigned)__builtin_amdgcn_s_getreg((3 << 11) | 20) & 0xFu; }
#define XB_SPIN(cond, bar) do { unsigned _sp = 0; while (cond) { __builtin_amdgcn_s_sleep(1); \
    if ((++_sp & 255u) == 0u) { if (xb_ld(&(bar)[XB_TMO])) break; if (_sp > XB_SPIN_CAP) { atomicAdd(&(bar)[XB_TMO], 1u); break; } } } } while (0)

struct XcdBarrier {
    unsigned* bar; unsigned x;
    volatile LAS unsigned* st;
};

__device__ __forceinline__ XcdBarrier xcd_barrier_post(unsigned* bar, volatile LAS unsigned* st) {
    XcdBarrier b; b.bar = bar; b.x = xb_xcc_id(); b.st = st;
    if (threadIdx.x == 0) (void)xb_add(&bar[XB_XCNT(b.x)], 1u);
    return b;
}
__device__ __forceinline__ void xcd_barrier_complete(unsigned* bar, unsigned x, unsigned& nloc, unsigned& nx) {
    const unsigned G = gridDim.x * gridDim.y * gridDim.z;
    unsigned sum, cnt, mine, sp = 0u;
    for (;;) {
        sum = 0u; cnt = 0u; mine = 0u;
#pragma unroll
        for (unsigned j = 0; j < 16; ++j) { const unsigned c = xb_ld(&bar[XB_XCNT(j)]); sum += c; cnt += (c > 0u) ? 1u : 0u; mine = (j == x) ? c : mine; }
        if (sum == G) break;
        __builtin_amdgcn_s_sleep(1);
        if ((++sp & 255u) == 0u) { if (xb_ld(&bar[XB_TMO])) break; if (sp > XB_SPIN_CAP) { atomicAdd(&bar[XB_TMO], 1u); break; } }
    }
    nloc = mine > 0u ? mine : 1u; nx = cnt > 0u ? cnt : 1u;
}

__device__ __forceinline__ void xcd_barrier(const XcdBarrier& b) {
    asm volatile("s_waitcnt vmcnt(0)" ::: "memory");
    __syncthreads();
    if (threadIdx.x == 0) {
        unsigned* bar = b.bar;
        __builtin_amdgcn_s_waitcnt(0);
        unsigned nloc = b.st[0], nx = b.st[1];
        if (nloc == 0u) { xcd_barrier_complete(bar, b.x, nloc, nx); b.st[0] = nloc; b.st[1] = nx; }
        const unsigned old = xb_add(&bar[XB_XSUB(b.x)], 1u);
        const unsigned gen = old / nloc;
        if (old + 1u == (gen + 1u) * nloc) {
            __builtin_amdgcn_fence(__ATOMIC_RELEASE, "agent");
            asm volatile("s_waitcnt vmcnt(0)" ::: "memory");
            const unsigned og = xb_add(&bar[XB_TOP], 1u);
            const unsigned tg = og / nx;
            if (og + 1u == (tg + 1u) * nx) xb_add(&bar[XB_TOPGEN], 1u);
            else XB_SPIN(xb_ld(&bar[XB_TOPGEN]) == tg, bar);
            __builtin_amdgcn_fence(__ATOMIC_ACQUIRE, "agent");
            xb_add(&bar[XB_XGEN(b.x)], 1u);
            asm volatile("s_waitcnt vmcnt(0)" ::: "memory");
        } else {
            XB_SPIN(xb_ld(&bar[XB_XGEN(b.x)]) == gen, bar);
            __builtin_amdgcn_fence(__ATOMIC_ACQUIRE, "agent");
            asm volatile("s_waitcnt vmcnt(0)" ::: "memory");
        }
    }
    __syncthreads();
}
constexpr int NWAVES = 8;
constexpr int RING_BYTES = 131072, LDSCTL_OFF = RING_BYTES, MISC_OFF = LDSCTL_OFF + 320, LDS_BYTES = 147456;
constexpr int CW_BAR = 4096;
constexpr size_t CTL_ZERO_BYTES = 65536;
struct Ctx { int lane, wave, tid, gw, NGW, gtid, NGT; unsigned char* lds; };

DEV void p_transpose(const Ctx& c, const float* __restrict__ W, bf16_t* WT, int K, int N, int ndst, int ldk, int koff, int mode) {
    float* scr = (float*)(c.lds + c.wave * (64 * 33 * 4)); const int lane = c.lane;
    const int nblk = ndst / 32, nitems = (K / 64) * nblk;
    for (int item = c.gw; item < nitems; item += c.NGW) {
        const int kb = item / nblk, nb = item % nblk, k0 = 64 * kb, n0 = 32 * nb, s0 = colmap(mode, n0);
#pragma unroll 8
        for (int i = 0; i < 32; ++i) { const int kk = 2 * i + (lane >> 5); scr[kk * 33 + (lane & 31)] = W[(size_t)(k0 + kk) * N + s0 + (lane & 31)]; }
        __builtin_amdgcn_wave_barrier(); asm volatile("s_waitcnt lgkmcnt(0)" ::: "memory");
        const int cc = lane & 7;
#pragma unroll
        for (int j = 0; j < 4; ++j) { const int n = (lane >> 3) + 8 * j; const float* s = scr + (8 * cc) * 33 + n;
            uint4 o; o.x = pk2(s[0 * 33], s[1 * 33]); o.y = pk2(s[2 * 33], s[3 * 33]); o.z = pk2(s[4 * 33], s[5 * 33]); o.w = pk2(s[6 * 33], s[7 * 33]);
            *(uint4*)(WT + (size_t)(n0 + n) * ldk + koff + k0 + 8 * cc) = o; }
        __builtin_amdgcn_wave_barrier(); asm volatile("s_waitcnt lgkmcnt(0)" ::: "memory");
    }
}
DEV void p_rms_in(const Ctx& c, const float* __restrict__ x, const float* __restrict__ g, bf16_t* out) {
    const int lane = c.lane;
    for (int row = c.gw; row < MTOK; row += c.NGW) {
        const float4* xr = (const float4*)(x + (size_t)row * DM); const float4* gr = (const float4*)g;
        float4 v[8]; float ss = 0.f;
#pragma unroll
        for (int j = 0; j < 8; ++j) { v[j] = xr[lane + 64 * j]; ss += v[j].x * v[j].x + v[j].y * v[j].y + v[j].z * v[j].z + v[j].w * v[j].w; }
        const float r = rsqrtf(wave_sum(ss) * (1.f / DM) + EPS);
        uint2* o = (uint2*)(out + (size_t)row * DM);
#pragma unroll
        for (int j = 0; j < 8; ++j) { const float4 gg = gr[lane + 64 * j]; uint2 w; w.x = pk2(v[j].x * r * gg.x, v[j].y * r * gg.y); w.y = pk2(v[j].z * r * gg.z, v[j].w * r * gg.w); o[lane + 64 * j] = w; }
    }
}
__device__ const float INV_FREQ[16] = {1.000000000e+00f, 4.403665960e-01f, 1.939227432e-01f, 8.539710194e-02f, 3.760603070e-02f, 1.656043902e-02f, 7.292664610e-03f, 3.211445874e-03f,
                                       1.414213562e-03f, 6.227723788e-04f, 2.742481884e-04f, 1.207697351e-04f, 5.318296098e-05f, 2.341999971e-05f, 1.031338616e-05f, 4.541670478e-06f};
DEV void p_rope_table(const Ctx& c, float* cosT, float* sinT) {
    for (int idx = c.gtid; idx < SEQ * 16; idx += c.NGT) { const int pos = idx >> 4, i = idx & 15; const float ang = (float)pos * INV_FREQ[i];
        cosT[idx] = (float)cos((double)ang); sinT[idx] = (float)sin((double)ang); }
}
DEV void p_sg_naive(const Ctx& c, const bf16_t* GU, const bf16_t* GV, const float* stats, const float* __restrict__ ln_g, const float* __restrict__ ln_b, const float* __restrict__ sgw, const float* __restrict__ sgb, bf16_t* AB) {
    for (int idx = c.gtid; idx < MTOK * 1024; idx += c.NGT) {
        const int col = idx & 1023, row = idx >> 10, g = col >> 7, t = row & 127, cb = row - t;
        const float* w = sgw + (size_t)(g * 128 + t) * 128; float acc = 0.f; const float lg = ln_g[col], lb = ln_b[col];
        for (int s = 0; s < 128; ++s) { const float mean = stats[2 * (cb + s)] * (1.f / 1024.f), var = stats[2 * (cb + s) + 1] * (1.f / 1024.f) - mean * mean, rstd = rsqrtf(var + EPS);
            acc += w[s] * ((bf2f(GV[(size_t)(cb + s) * 1024 + col]) - mean) * rstd * lg + lb); }
        acc += sgb[g * 128 + t];
        AB[(size_t)row * 2048 + col] = f2bf(bf2f(GU[(size_t)row * 1024 + col]) * acc);
    }
}
DEV void p_attn_naive(const Ctx& c, const bf16_t* Q, const bf16_t* Kb, const bf16_t* Vb, const float* __restrict__ sink, bf16_t* AB) {
    const int lane = c.lane;
    for (int idx = c.gw; idx < MTOK * 8; idx += c.NGW) {
        const int row = idx >> 3, h = idx & 7, kvh = h >> 2, b = row / SEQ, pos = row % SEQ;
        const unsigned qq = *(const unsigned*)(Q + (size_t)row * 1024 + h * 128 + 2 * lane); const float q0 = __uint_as_float(qq << 16), q1 = __uint_as_float(qq & 0xffff0000u);
        float m = sink[h] * LOG2E, l = 1.f, o0 = 0.f, o1 = 0.f;
        const int klo = pos - 128 < 0 ? 0 : pos - 128, khi = pos + 128 > SEQ - 1 ? SEQ - 1 : pos + 128;
        for (int kp = klo; kp <= khi; ++kp) { const size_t kr = (size_t)(b * SEQ + kp) * 256 + kvh * 128 + 2 * lane;
            const unsigned kk = *(const unsigned*)(Kb + kr), vv = *(const unsigned*)(Vb + kr);
            const float s = wave_sum(q0 * __uint_as_float(kk << 16) + q1 * __uint_as_float(kk & 0xffff0000u));
            const float mn = fmaxf(m, s), a = exp2f(m - mn), p = exp2f(s - mn);
            l = l * a + p; o0 = o0 * a + p * __uint_as_float(vv << 16); o1 = o1 * a + p * __uint_as_float(vv & 0xffff0000u); m = mn; }
        const float il = 1.f / l;
        *(unsigned*)(AB + (size_t)row * 2048 + 1024 + h * 128 + 2 * lane) = pk2(o0 * il, o1 * il);
    }
}
DEV void p_post4(const Ctx& c, const float* Y, const float* __restrict__ x, const float* __restrict__ g1, const float* __restrict__ g2, float* out, bf16_t* HF) {
    const int lane = c.lane;
    for (int row = c.gw; row < MTOK; row += c.NGW) {
        const float4* yr = (const float4*)(Y + (size_t)row * DM); const float4* xr = (const float4*)(x + (size_t)row * DM);
        float4 v[8]; float ss = 0.f;
#pragma unroll
        for (int j = 0; j < 8; ++j) { v[j] = yr[lane + 64 * j]; ss += v[j].x * v[j].x + v[j].y * v[j].y + v[j].z * v[j].z + v[j].w * v[j].w; }
        const float r1 = rsqrtf(wave_sum(ss) * (1.f / DM) + EPS); float s2 = 0.f;
#pragma unroll
        for (int j = 0; j < 8; ++j) { const float4 gg = ((const float4*)g1)[lane + 64 * j], xx = xr[lane + 64 * j];
            v[j].x = xx.x + v[j].x * r1 * gg.x; v[j].y = xx.y + v[j].y * r1 * gg.y; v[j].z = xx.z + v[j].z * r1 * gg.z; v[j].w = xx.w + v[j].w * r1 * gg.w;
            s2 += v[j].x * v[j].x + v[j].y * v[j].y + v[j].z * v[j].z + v[j].w * v[j].w; ((float4*)(out + (size_t)row * DM))[lane + 64 * j] = v[j]; }
        const float r2 = rsqrtf(wave_sum(s2) * (1.f / DM) + EPS);
#pragma unroll
        for (int j = 0; j < 8; ++j) { const float4 gg = ((const float4*)g2)[lane + 64 * j]; uint2 w; w.x = pk2(v[j].x * r2 * gg.x, v[j].y * r2 * gg.y); w.y = pk2(v[j].z * r2 * gg.z, v[j].w * r2 * gg.w);
            ((uint2*)(HF + (size_t)row * DM))[lane + 64 * j] = w; }
    }
}
DEV void p_conv_naive(const Ctx& c, const bf16_t* U, const float* __restrict__ cw, const float* __restrict__ cb, bf16_t* H) {
    for (int idx = c.gtid; idx < SEQ * DFF; idx += c.NGT) {
        const int cc = idx % DFF, t = idx / DFF, j = cc >> 7, ci = cc & 127, gcol = 256 * j + ci, vcol = gcol + 128, og = cc, ov = DFF + cc;
        float cg = cb[og], cv = cb[ov];
#pragma unroll
        for (int jj = 0; jj < 3; ++jj) { const int tt = t + jj - 1; if (tt >= 0 && tt < SEQ) { cg += cw[jj * UPW + og] * bf2f(U[(size_t)tt * UPW + gcol]); cv += cw[jj * UPW + ov] * bf2f(U[(size_t)tt * UPW + vcol]); } }
        H[(size_t)t * DFF + cc] = f2bf(gelu_tanh(cg) * cv);
    }
}
DEV void p_post6(const Ctx& c, const float* F, const float* __restrict__ g, float* out) {
    const int lane = c.lane;
    for (int row = c.gw; row < MTOK; row += c.NGW) {
        const float4* fr = (const float4*)(F + (size_t)row * DM); float4* orow = (float4*)(out + (size_t)row * DM);
        float4 v[8]; float ss = 0.f;
#pragma unroll
        for (int j = 0; j < 8; ++j) { v[j] = fr[lane + 64 * j]; ss += v[j].x * v[j].x + v[j].y * v[j].y + v[j].z * v[j].z + v[j].w * v[j].w; }
        const float r = rsqrtf(wave_sum(ss) * (1.f / DM) + EPS);
#pragma unroll
        for (int j = 0; j < 8; ++j) { const float4 gg = ((const float4*)g)[lane + 64 * j]; float4 xx = orow[lane + 64 * j];
            xx.x += v[j].x * r * gg.x; xx.y += v[j].y * r * gg.y; xx.z += v[j].z * r * gg.z; xx.w += v[j].w * r * gg.w; orow[lane + 64 * j] = xx; }
    }
}

namespace att {
typedef short bf16x8 __attribute__((ext_vector_type(8)));
typedef short s16x4 __attribute__((ext_vector_type(4)));
typedef float f32x16 __attribute__((ext_vector_type(16)));
typedef float f32x4 __attribute__((ext_vector_type(4)));
typedef unsigned u32x4 __attribute__((ext_vector_type(4)));
constexpr int KVBLK = 64, SHM_V = KVBLK * 128 * 2, SHM_K = KVBLK * 128 * 2;
constexpr int LDS_V = 0, LDS_K = 2 * SHM_V, LDS_WS = 2 * SHM_V + 2 * SHM_K;
#define KSWZ(row, colB) ((row) * 256 + ((colB) ^ (((row) & 7) << 4)))
#define SBAR() __builtin_amdgcn_sched_barrier(0)
DEV int v_st(int k, int c) { const int kk = (k & ~0xC) | ((k & 4) << 1) | ((k & 8) >> 1); return ((kk >> 3) * 4 + (c >> 5)) * 512 + ((kk & 7) * 32 + (c & 31)) * 2; }
DEV int v_rd_base(int lane) { return ((lane & 3) << 3) | (((lane >> 2) & 3) << 6) | (((lane >> 4) & 1) << 5) | (((lane >> 5) & 1) << 8); }
constexpr int v_rd_off(int d0, int ks, int half) { return d0 * 512 + ks * 4096 + half * 2048; }
DEV int crow(int r, int hi) { return (r & 3) + 8 * (r >> 2) + 4 * hi; }
DEV unsigned cvtpk(float lo, float hi) { unsigned r; asm volatile("v_cvt_pk_bf16_f32 %0, %1, %2" : "=v"(r) : "v"(lo), "v"(hi)); return r; }
DEV bf16x8 pack8(f32x4 a, f32x4 b) { u32x4 w = {cvtpk(a[0], a[1]), cvtpk(a[2], a[3]), cvtpk(b[0], b[1]), cvtpk(b[2], b[3])}; return *reinterpret_cast<bf16x8*>(&w); }

template <int KB> DEV void qkt(f32x16& p0, f32x16& p1, const char* K_lds, int r32, int hi, const bf16x8* qr) {
    p0 = f32x16{}; p1 = f32x16{};
    const char* kb[4];
#pragma unroll
    for (int dd = 0; dd < 4; ++dd) kb[dd] = K_lds + KB * SHM_K + KSWZ(r32, (dd * 16 + hi * 8) * 2);
#pragma unroll
    for (int d0 = 0; d0 < 8; ++d0) { const char* a = kb[d0 & 3] + (d0 >> 2) * 128;
        const bf16x8 b0 = *reinterpret_cast<const bf16x8*>(a);
        const bf16x8 b1 = *reinterpret_cast<const bf16x8*>(a + 32 * 256);
        p0 = __builtin_amdgcn_mfma_f32_32x32x16_bf16(b0, qr[d0], p0, 0, 0, 0);
        p1 = __builtin_amdgcn_mfma_f32_32x32x16_bf16(b1, qr[d0], p1, 0, 0, 0); }
}
#define TRRD(dst, off) asm volatile("ds_read_b64_tr_b16 %0, %1 offset:%2" : "=&v"(dst) : "v"(vb0), "i"(off) : "memory")
#define PV_D0(OI, d0, VB) do { s16x4 l0, l1, l2, l3, h0, h1, h2, h3; constexpr int b_ = (VB) * SHM_V + v_rd_off(d0, 0, 0); \
        TRRD(l0, b_); TRRD(h0, b_ + 2048); TRRD(l1, b_ + 4096); TRRD(h1, b_ + 6144); TRRD(l2, b_ + 8192); TRRD(h2, b_ + 10240); TRRD(l3, b_ + 12288); TRRD(h3, b_ + 14336); \
        asm volatile("s_waitcnt lgkmcnt(0)" ::: "memory"); SBAR(); \
        o[OI] = __builtin_amdgcn_mfma_f32_32x32x16_bf16(pa0, (bf16x8){l0[0], l0[1], l0[2], l0[3], h0[0], h0[1], h0[2], h0[3]}, o[OI], 0, 0, 0); \
        o[OI] = __builtin_amdgcn_mfma_f32_32x32x16_bf16(pa1, (bf16x8){l1[0], l1[1], l1[2], l1[3], h1[0], h1[1], h1[2], h1[3]}, o[OI], 0, 0, 0); \
        o[OI] = __builtin_amdgcn_mfma_f32_32x32x16_bf16(pa2, (bf16x8){l2[0], l2[1], l2[2], l2[3], h2[0], h2[1], h2[2], h2[3]}, o[OI], 0, 0, 0); \
        o[OI] = __builtin_amdgcn_mfma_f32_32x32x16_bf16(pa3, (bf16x8){l3[0], l3[1], l3[2], l3[3], h3[0], h3[1], h3[2], h3[3]}, o[OI], 0, 0, 0); } while (0)
template <int VB> DEV void pv_tile(f32x16* o, int vb0, bf16x8 pa0, bf16x8 pa1, bf16x8 pa2, bf16x8 pa3) { PV_D0(0, 0, VB); PV_D0(1, 1, VB); PV_D0(2, 2, VB); PV_D0(3, 3, VB); }
template <int VB> DEV void pv_half(f32x16* o, int vb0, bf16x8 pa0, bf16x8 pa1, bf16x8 pa2, bf16x8 pa3) { PV_D0(0, 0, VB); PV_D0(1, 1, VB); }

DEV void attn_unit(unsigned char* lds, const bf16_t* Qg, const bf16_t* Kg, const bf16_t* Vg, const float* __restrict__ sink, bf16_t* AB, int b, int n, int hp) {
    int tid_ = threadIdx.x; asm volatile("" : "+v"(tid_));
    const int tid = tid_, wid = __builtin_amdgcn_readfirstlane(tid >> 6), lane = tid & 63, r32 = lane & 31, hi = lane >> 5;
    const int head = 2 * hp + (wid >> 2), kvh = hp >> 1, qpos = n * 128 + (wid & 3) * 32 + r32;
    char* V_lds = (char*)lds + LDS_V; char* K_lds = (char*)lds + LDS_K; float* ws = (float*)(lds + LDS_WS) + wid * 64; float* li_l = ws; float* al_l = ws + 32;
    bf16x8 qr[8];
#pragma unroll
    for (int d0 = 0; d0 < 8; ++d0) qr[d0] = *reinterpret_cast<const bf16x8*>(Qg + (size_t)(b * SEQ + qpos) * 1024 + head * 128 + d0 * 16 + hi * 8);
    float m_reg = sink[head] * LOG2E, l_reg = 1.f; f32x16 o[4] = {};
    const int sr = tid >> 4, sc = (tid & 15) * 8, vst0 = v_st(sr, sc), vst1 = v_st(32 + sr, sc), kws = KSWZ(sr, sc * 2);
    const int vb0 = (int)(uintptr_t)V_lds + v_rd_base(lane);
    const int jlo = n >= 1 ? 2 * n - 2 : 0, jhi = n <= 30 ? 2 * n + 4 : 64, NT = jhi - jlo;
    const bf16_t* Kh = Kg + (size_t)b * SEQ * 256 + kvh * 128 + sc; const bf16_t* Vh = Vg + (size_t)b * SEQ * 256 + kvh * 128 + sc;
    bf16x8 st_k0, st_k1, st_v0, st_v1;
#define SLOAD(k0) do { st_v0 = *reinterpret_cast<const bf16x8*>(Vh + (size_t)((k0) + sr) * 256); st_v1 = *reinterpret_cast<const bf16x8*>(Vh + (size_t)((k0) + 32 + sr) * 256); \
                       st_k0 = *reinterpret_cast<const bf16x8*>(Kh + (size_t)((k0) + sr) * 256); st_k1 = *reinterpret_cast<const bf16x8*>(Kh + (size_t)((k0) + 32 + sr) * 256); } while (0)
#define SWRITE(bf) do { *(bf16x8*)(V_lds + (bf) * SHM_V + vst0) = st_v0; *(bf16x8*)(V_lds + (bf) * SHM_V + vst1) = st_v1; \
                        *(bf16x8*)(K_lds + (bf) * SHM_K + kws) = st_k0; *(bf16x8*)(K_lds + (bf) * SHM_K + kws + 32 * 256) = st_k1; } while (0)
#define PK4(P, B_, OUT) do { unsigned a0 = cvtpk(P[B_ + 0], P[B_ + 1]), a1 = cvtpk(P[B_ + 2], P[B_ + 3]); unsigned b0 = cvtpk(P[B_ + 4], P[B_ + 5]), b1 = cvtpk(P[B_ + 6], P[B_ + 7]); \
        auto r0 = __builtin_amdgcn_permlane32_swap(a0, b0, false, false); auto r1 = __builtin_amdgcn_permlane32_swap(a1, b1, false, false); \
        u32x4 w = {r0[0], r1[0], r0[1], r1[1]}; OUT = *reinterpret_cast<bf16x8*>(&w); } while (0)
#define STEP(t, BUF, NXT) do { \
        if ((t) + 1 < NT) SLOAD((jlo + (t) + 1) * KVBLK); \
        f32x16 p0, p1; SBAR(); qkt<BUF>(p0, p1, K_lds, r32, hi, qr); \
        { const int dq = (jlo + (t)) * KVBLK + 4 * hi - qpos + 128; const float NEG = -__builtin_inff(); \
          _Pragma("unroll") for (int r = 0; r < 16; ++r) { const int cc = (r & 3) + 8 * (r >> 2); if ((unsigned)(dq + cc) > 256u) p0[r] = NEG; if ((unsigned)(dq + cc + 32) > 256u) p1[r] = NEG; } } \
        float pmax = p0[0]; _Pragma("unroll") for (int r = 1; r < 16; ++r) pmax = fmaxf(pmax, p0[r]); _Pragma("unroll") for (int r = 0; r < 16; ++r) pmax = fmaxf(pmax, p1[r]); \
        { auto rr = __builtin_amdgcn_permlane32_swap(__float_as_uint(pmax), __float_as_uint(pmax), false, false); pmax = fmaxf(__uint_as_float(rr[0]), __uint_as_float(rr[1])); } \
        float alpha = 1.f; \
        if (!__all(pmax - m_reg <= 8.f)) { const float mn = fmaxf(m_reg, pmax); alpha = __builtin_amdgcn_exp2f(m_reg - mn); m_reg = mn; } \
        _Pragma("unroll") for (int r = 0; r < 16; ++r) { p0[r] = __builtin_amdgcn_exp2f(p0[r] - m_reg); p1[r] = __builtin_amdgcn_exp2f(p1[r] - m_reg); } \
        float ps = 0.f; _Pragma("unroll") for (int r = 0; r < 16; ++r) ps += p0[r] + p1[r]; \
        { auto rr = __builtin_amdgcn_permlane32_swap(__float_as_uint(ps), __float_as_uint(ps), false, false); ps = __uint_as_float(rr[0]) + __uint_as_float(rr[1]); } \
        l_reg = l_reg * alpha + ps; \
        bf16x8 pa0, pa1, pa2, pa3; PK4(p0, 0, pa0); PK4(p0, 8, pa1); PK4(p1, 0, pa2); PK4(p1, 8, pa3); \
        if (__any(alpha < 1.f)) { if (hi == 0) al_l[r32] = alpha; asm volatile("s_waitcnt lgkmcnt(0)" ::: "memory"); \
            _Pragma("unroll") for (int d_ = 0; d_ < 4; ++d_) _Pragma("unroll") for (int r = 0; r < 16; ++r) o[d_][r] *= al_l[crow(r, hi)]; } \
        SBAR(); pv_tile<BUF>(o, vb0, pa0, pa1, pa2, pa3); \
        if ((t) + 1 < NT) SWRITE(NXT); \
        __syncthreads(); } while (0)
    SLOAD(jlo * KVBLK); SWRITE(0); __syncthreads();
    for (int t = 0; t < NT; t += 2) { STEP(t, 0, 1); STEP(t + 1, 1, 0); }
    if (hi == 0) li_l[r32] = l_reg; asm volatile("s_waitcnt lgkmcnt(0)" ::: "memory");
    bf16_t* Ow = AB + (size_t)(b * SEQ + n * 128 + (wid & 3) * 32) * 2048 + 1024 + head * 128;
#pragma unroll
    for (int r = 0; r < 16; ++r) { const int orow = crow(r, hi); const float rl = __builtin_amdgcn_rcpf(li_l[orow]);
#pragma unroll
        for (int d0 = 0; d0 < 4; ++d0) { const float v = o[d0][r] * rl; const float vn = __shfl_xor(v, 1);
            if ((r32 & 1) == 0) *(unsigned*)(Ow + (size_t)orow * 2048 + d0 * 32 + r32) = cvtpk(v, vn); } }
    __syncthreads();
#undef STEP
#undef SLOAD
#undef SWRITE
}

DEV void sg_unit(unsigned char* lds, const bf16_t* GU, const bf16_t* GV, const float* stats, const float* __restrict__ ln_g, const float* __restrict__ ln_b, const float* __restrict__ sgw, const float* __restrict__ sgb, bf16_t* AB, int ci, int g) {
    int tid_ = threadIdx.x; asm volatile("" : "+v"(tid_));
    const int tid = tid_, wid = __builtin_amdgcn_readfirstlane(tid >> 6), lane = tid & 63, r32 = lane & 31, hi = lane >> 5, tb = wid & 3, dh = wid >> 2;
    char* V_lds = (char*)lds + LDS_V; const int cb = ci * 128;
    const int sr = tid >> 4, sc = (tid & 15) * 8;
    { const f32x4 g0 = *(const f32x4*)(ln_g + g * 128 + sc), g1 = *(const f32x4*)(ln_g + g * 128 + sc + 4), b0 = *(const f32x4*)(ln_b + g * 128 + sc), b1 = *(const f32x4*)(ln_b + g * 128 + sc + 4);
#pragma unroll
      for (int q = 0; q < 4; ++q) { const int s = sr + 32 * q, row = cb + s;
          const float mean = stats[2 * row] * (1.f / 1024.f), var = stats[2 * row + 1] * (1.f / 1024.f) - mean * mean, rstd = rsqrtf(var + EPS);
          const u32x4 raw = *(const u32x4*)(GV + (size_t)row * 1024 + g * 128 + sc);
          f32x4 a, bb; a[0] = __uint_as_float(raw.x << 16); a[1] = __uint_as_float(raw.x & 0xffff0000u); a[2] = __uint_as_float(raw.y << 16); a[3] = __uint_as_float(raw.y & 0xffff0000u);
          bb[0] = __uint_as_float(raw.z << 16); bb[1] = __uint_as_float(raw.z & 0xffff0000u); bb[2] = __uint_as_float(raw.w << 16); bb[3] = __uint_as_float(raw.w & 0xffff0000u);
          a = (a - mean) * rstd * g0 + b0; bb = (bb - mean) * rstd * g1 + b1;
          *(bf16x8*)(V_lds + (q >> 1) * SHM_V + v_st(s & 63, sc)) = pack8(a, bb); } }
    bf16x8 pw[8]; { const float* wrow = sgw + (size_t)(g * 128 + tb * 32 + r32) * 128 + hi * 8;
#pragma unroll
      for (int f = 0; f < 8; ++f) pw[f] = pack8(*(const f32x4*)(wrow + 16 * f), *(const f32x4*)(wrow + 16 * f + 4)); }
    __syncthreads();
    f32x16 o[2] = {}; const int vb0 = (int)(uintptr_t)V_lds + v_rd_base(lane) + dh * 1024;
    pv_half<0>(o, vb0, pw[0], pw[1], pw[2], pw[3]);
    pv_half<1>(o, vb0, pw[4], pw[5], pw[6], pw[7]);
    const int row0 = cb + tb * 32, col0 = g * 128 + dh * 64;
#pragma unroll
    for (int r = 0; r < 16; ++r) { const int t = tb * 32 + crow(r, hi); const float bias = sgb[g * 128 + t];
#pragma unroll
        for (int i = 0; i < 2; ++i) { const size_t row = (size_t)(row0 + crow(r, hi)); const int col = col0 + 32 * i + r32;
            const float v = bf2f(GU[row * 1024 + col]) * (o[i][r] + bias); const float vn = __shfl_xor(v, 1);
            if ((r32 & 1) == 0) *(unsigned*)(AB + row * 2048 + col) = cvtpk(v, vn); } }
    __syncthreads();
}
#undef TRRD
#undef PV_D0
#undef PK4
#undef SBAR
}
DEV void p_mixers(unsigned char* lds, int G, const bf16_t* GU, const bf16_t* GV, const float* stats, const float* ln_g, const float* ln_b, const float* sgw, const float* sgb,
                  const bf16_t* Qg, const bf16_t* Kg, const bf16_t* Vg, const float* sink, bf16_t* AB) {
    for (int u = blockIdx.x; u < NB * 32 * 4; u += G) { const int hp = u & 3, n = (u >> 2) & 31, b = u >> 7; att::attn_unit(lds, Qg, Kg, Vg, sink, AB, b, n, hp); }
    for (int u = blockIdx.x; u < 64 * 8; u += G) att::sg_unit(lds, GU, GV, stats, ln_g, ln_b, sgw, sgb, AB, u >> 3, u & 7);
}

struct Params { const float* in[18]; float* out; unsigned char* ws; };
__global__ void __launch_bounds__(NWAVES * 64, 2) mk_fwd(Params p) {
    extern __shared__ __attribute__((aligned(16))) unsigned char lds[];
    const int G = gridDim.x;
    LAS unsigned char* ldsl = (LAS unsigned char*)lds;
    for (int u = threadIdx.x; u < (LDS_BYTES - LDSCTL_OFF) / 4; u += NWAVES * 64) ((LAS unsigned*)(ldsl + LDSCTL_OFF))[u] = 0u;
    __syncthreads();
    XcdBarrier bar = xcd_barrier_post((unsigned*)(p.ws + WS_CTL) + CW_BAR, (volatile LAS unsigned*)(ldsl + MISC_OFF) + 8);
#define MKCTX() Ctx c; { int t_ = threadIdx.x; asm volatile("" : "+v"(t_)); c.tid = t_; c.lane = t_ & 63; c.wave = __builtin_amdgcn_readfirstlane(t_ >> 6); \
        c.gw = blockIdx.x * NWAVES + c.wave; c.NGW = G * NWAVES; c.gtid = blockIdx.x * (NWAVES * 64) + t_; c.NGT = G * NWAVES * 64; c.lds = lds; }
#define WSP(T, off) ((T*)(p.ws + (off)))
#define x_in p.in[0]
#define norm_mix_pre p.in[1]
#define w_in p.in[2]
#define sg_ln_g p.in[3]
#define sg_ln_b p.in[4]
#define sg_w p.in[5]
#define sg_b p.in[6]
#define attn_sink p.in[7]
#define w_a p.in[8]
#define w_b p.in[9]
#define w_out p.in[10]
#define norm_mix_post p.in[11]
#define norm_ffn_pre p.in[12]
#define w_up p.in[13]
#define conv_w p.in[14]
#define conv_b p.in[15]
#define w_down p.in[16]
#define norm_ffn_post p.in[17]
#define out_f p.out
#define WinT WSP(bf16_t, WS_WIN)
#define WabT WSP(bf16_t, WS_WAB)
#define WoT WSP(bf16_t, WS_WO)
#define WupT WSP(bf16_t, WS_WUP)
#define WdT WSP(bf16_t, WS_WDN)
#define XN WSP(bf16_t, WS_XN)
#define GU WSP(bf16_t, WS_GU)
#define GV WSP(bf16_t, WS_GV)
#define STATS WSP(float, WS_STATS)
#define Q WSP(bf16_t, WS_Q)
#define Kb WSP(bf16_t, WS_K)
#define Vb WSP(bf16_t, WS_V)
#define RA WSP(bf16_t, WS_RA)
#define SB WSP(bf16_t, WS_SB)
#define AB WSP(bf16_t, WS_AB)
#define P1 WSP(float, WS_P1)
#define MG WSP(bf16_t, WS_MG)
#define Y WSP(float, WS_Y)
#define HF WSP(bf16_t, WS_HF)
#define U WSP(bf16_t, WS_U)
#define H WSP(bf16_t, WS_H)
#define F WSP(float, WS_F)
#define cosT WSP(float, WS_ROPE)
#define sinT (WSP(float, WS_ROPE) + SEQ * 16)
#define GRID_BAR() xcd_barrier(bar)
#define GEMM(EPI, ...) pg8::gemm_phase<EPI, pg8::StaticOrder, true, true>(ldsl, __VA_ARGS__)
    { MKCTX();
    p_transpose(c, w_in, WinT, DM, INW, INW, DM, 0, 1);
    p_transpose(c, w_a, WabT, 1024, DM, DM, 2048, 0, 0);
    p_transpose(c, w_b, WabT, 1024, DM, DM, 2048, 1024, 0);
    p_transpose(c, w_out, WoT, DM, DM, DM, DM, 0, 0);
    p_transpose(c, w_up, WupT, DM, UPW, UPW, DM, 0, 2);
    p_transpose(c, w_down, WdT, DFF, DM, DM, DFF, 0, 0);
    p_rms_in(c, x_in, norm_mix_pre, XN);
    p_rope_table(c, cosT, sinT);
    for (int i = c.gtid; i < MTOK * 2; i += c.NGT) STATS[i] = 0.f; }
    GRID_BAR();
    { pg8::Gemm g{XN, WinT, MTOK, INW, DM, DM, DM, 0}; pg8::StaticOrder S; S.init(g.M, g.N, G, (int)blockIdx.x);
      pg8::EpiIn E{GU, GV, Q, Kb, Vb, RA, SB, STATS, cosT, sinT}; GEMM(pg8::EpiIn, g, S, E); }
    GRID_BAR();
    p_mixers(lds, G, GU, GV, STATS, sg_ln_g, sg_ln_b, sg_w, sg_b, Q, Kb, Vb, attn_sink, AB);
    GRID_BAR();
    { pg8::Gemm g{AB, WabT, MTOK, DM, 1024, 2048, 2048, 0}; pg8::StaticOrder S; S.init(g.M, g.N, G, (int)blockIdx.x); pg8::EpiF32 E{P1, RA, DM, DM}; GEMM(pg8::EpiF32, g, S, E); }
    GRID_BAR();
    { pg8::Gemm g{AB + 1024, WabT + 1024, MTOK, DM, 1024, 2048, 2048, 0}; pg8::StaticOrder S; S.init(g.M, g.N, G, (int)blockIdx.x); pg8::EpiMerge E{MG, P1, SB, DM, 0}; GEMM(pg8::EpiMerge, g, S, E); }
    GRID_BAR();
    { pg8::Gemm g{MG, WoT, MTOK, DM, DM, DM, DM, 0}; pg8::StaticOrder S; S.init(g.M, g.N, G, (int)blockIdx.x); pg8::EpiF32 E{Y, nullptr, DM, 0}; GEMM(pg8::EpiF32, g, S, E); }
    GRID_BAR();
    { MKCTX(); p_post4(c, Y, x_in, norm_mix_post, norm_ffn_pre, out_f, HF); }
    GRID_BAR();
    for (int b = 0; b < NB; ++b) {
        { pg8::Gemm g{HF + (size_t)b * SEQ * DM, WupT, SEQ, UPW, DM, DM, DM, 0}; pg8::StaticOrder S; S.init(g.M, g.N, G, (int)blockIdx.x); pg8::EpiBf16Plain E{U, UPW, 0}; GEMM(pg8::EpiBf16Plain, g, S, E); }
        GRID_BAR();
        { MKCTX(); p_conv_naive(c, U, conv_w, conv_b, H + (size_t)b * SEQ * DFF); }
        GRID_BAR();
    }
    { pg8::Gemm g{H, WdT, MTOK, DM, DFF, DFF, DFF, 0}; pg8::StaticOrder S; S.init(g.M, g.N, G, (int)blockIdx.x); pg8::EpiF32 E{F, nullptr, DM, 0}; GEMM(pg8::EpiF32, g, S, E); }
    GRID_BAR();
    { MKCTX(); p_post6(c, F, norm_ffn_post, out_f); }
#undef x_in
#undef out_f
#undef Q
#undef U
#undef H
#undef F
#undef Y
}

extern "C" void kernel_launch(void* const* d_in, const int* in_sizes, int n_in, void* d_out, int out_size, void* d_ws, size_t ws_size, hipStream_t stream) {
    (void)in_sizes; (void)out_size;
    static int grid = 0;
    if (grid == 0) {
        if (n_in != 18 || ws_size < WS_END) { fprintf(stderr, "kernel_launch: bad inputs / workspace (%d, %zu)\n", n_in, ws_size); grid = -1; return; }
        int dev = 0, cus = 0, per_cu = 0;
        if (hipGetDevice(&dev) != hipSuccess || hipDeviceGetAttribute(&cus, hipDeviceAttributeMultiprocessorCount, dev) != hipSuccess) { grid = -1; return; }
        if (hipFuncSetAttribute((const void*)mk_fwd, hipFuncAttributeMaxDynamicSharedMemorySize, LDS_BYTES) != hipSuccess) { fprintf(stderr, "kernel_launch: hipFuncSetAttribute failed\n"); grid = -1; return; }
        if (hipOccupancyMaxActiveBlocksPerMultiprocessor(&per_cu, (const void*)mk_fwd, NWAVES * 64, LDS_BYTES) != hipSuccess || per_cu < 1) { fprintf(stderr, "kernel_launch: occupancy query says %d blocks/CU\n", per_cu); (void)hipGetLastError(); }
        grid = cus;
    }
    if (grid < 0) return;
    (void)hipMemsetAsync((char*)d_ws + WS_CTL, 0, CTL_ZERO_BYTES, stream);
    Params p{}; for (int i = 0; i < 18; ++i) p.in[i] = (const float*)d_in[i]; p.out = (float*)d_out; p.ws = (unsigned char*)d_ws;
    hipLaunchKernelGGL(mk_fwd, dim3(grid), dim3(NWAVES * 64), LDS_BYTES, stream, p);
}
```

```cpp
#include <hip/hip_runtime.h>
#include <cstdio>
#include <cstdint>
namespace pg8 {
#define PG8_LAS __attribute__((address_space(3)))
typedef unsigned short bf16_t;
typedef short bf16x8 __attribute__((ext_vector_type(8)));
typedef float f32x4 __attribute__((ext_vector_type(4)));
typedef unsigned u32x4 __attribute__((ext_vector_type(4)));
constexpr int BM = 256, BK = 64, HALF = 128, HTB = HALF * BK * 2  , STAGE_BYTES = 8 * HTB, NXCD = 8, WGM = 8;

__host__ __device__ __forceinline__ int lds_byte(int r, int c) { const int st = (r >> 4) * 2 + (c >> 5), rr = r & 15, cc = c & 31, ob = rr * 64 + cc * 2; return st * 1024 + (ob ^ (((ob >> 9) & 1) << 5)); }
__host__ __device__ __forceinline__ void stage_rc(int b, int& R, int& C) { const int st = b / 1024, sb = b % 1024, swz = sb ^ (((sb >> 9) & 1) << 5); R = (st >> 1) * 16 + swz / 64; C = (st & 1) * 32 + (swz % 64) / 2; }
__host__ __device__ __forceinline__ int perm32(int rho) { const int n = rho >> 4, i = rho & 15; return 8 * (i >> 2) + 4 * n + (i & 3); }

struct Unit { int pm, pn; };
struct Gemm { const bf16_t* A; const bf16_t* Bt; int M, N, K, lda, ldb, pad; };

struct StaticOrder {
    int nM, nN, nwg, G, c;
    __host__ __device__ void init(int M, int N, int G_, int c_) { nM = M / BM; nN = N / BM; nwg = nM * nN; G = G_; c = c_; }
    __host__ __device__ bool next(int i, Unit& u) const {
        const long L = (long)i * G + c; if (L >= nwg) return false;
        int wgid = (int)L; { const int q = nwg / NXCD, r = nwg % NXCD, xcd = wgid % NXCD, off = wgid / NXCD; wgid = (xcd < r ? xcd * (q + 1) : r * (q + 1) + (xcd - r) * q) + off; }
        const int nig = WGM * nN, gid = wgid / nig, fm = gid * WGM, gsz = (nM - fm) < WGM ? (nM - fm) : WGM;
        u.pm = fm + ((wgid % nig) % gsz); u.pn = (wgid % nig) / gsz; return true;
    }
    __device__ __forceinline__ void a_ready(const Unit&) const {}
    __device__ __forceinline__ void done(const Unit&) const {}
};


__device__ __forceinline__ unsigned cvt_pk_bf16(float lo, float hi) { unsigned r; asm volatile("v_cvt_pk_bf16_f32 %0, %1, %2" : "=v"(r) : "v"(lo), "v"(hi)); return r; }
typedef unsigned u32x2 __attribute__((ext_vector_type(2)));
__device__ __forceinline__ float gelu_t(float x) { const float u = 0.7978845608028654f * (x + 0.044715f * x * x * x); return x / (1.f + __expf(-2.f * u)); }
struct EpiIn {
    static constexpr bool PERM = true, AFTER_DRAIN = false, HALO = false;
    bf16_t* GU; bf16_t* GV; bf16_t* Q; bf16_t* Kb; bf16_t* Vb; bf16_t* RA; bf16_t* SB; float* stats; const float* cosT; const float* sinT;
    __device__ __forceinline__ static u32x4 pack8(const f32x4 v0, const f32x4 v1) { u32x4 w; w.x = cvt_pk_bf16(v0[0], v0[1]); w.y = cvt_pk_bf16(v0[2], v0[3]); w.z = cvt_pk_bf16(v1[0], v1[1]); w.w = cvt_pk_bf16(v1[2], v1[3]); return w; }
    __device__ __forceinline__ void operator()(const f32x4 (&acc)[2][2][4][2], const Unit& u, int wr, int wc, int fr, int fq) const {
        const int row0 = u.pm * BM + wr * 64 + fr, c8 = wc * 32 + 8 * fq, pn = u.pn;
        if (pn < 8) {
            bf16_t* O = pn < 4 ? GU : GV; const int colt = (pn & 3) * 256 + c8; const bool st = pn >= 4;
#pragma unroll
            for (int ai = 0; ai < 2; ++ai)
#pragma unroll
                for (int m = 0; m < 4; ++m) { const int row = row0 + ai * HALF + m * 16; float s = 0.f, q = 0.f;
#pragma unroll
                    for (int bj = 0; bj < 2; ++bj) { f32x4 v0 = acc[ai][bj][m][0], v1 = acc[ai][bj][m][1];
#pragma unroll
                        for (int k = 0; k < 4; ++k) { v0[k] = gelu_t(v0[k]); v1[k] = gelu_t(v1[k]); s += v0[k] + v1[k]; q += v0[k] * v0[k] + v1[k] * v1[k]; }
                        *(u32x4*)(O + (size_t)row * 1024 + colt + bj * HALF) = pack8(v0, v1); }
                    if (st) { s += __shfl_xor(s, 16); s += __shfl_xor(s, 32); q += __shfl_xor(q, 16); q += __shfl_xor(q, 32);
                        if (fq == 0) { atomicAdd(stats + 2 * row, s); atomicAdd(stats + 2 * row + 1, q); } } }
        } else if (pn < 13) {
            const bool isq = pn < 12; bf16_t* O = isq ? Q + (pn - 8) * 256 : Kb; const int ld = isq ? 1024 : 256; const float sc = isq ? 0.08838834764831845f * 1.4426950408889634f : 1.f;
#pragma unroll
            for (int ai = 0; ai < 2; ++ai)
#pragma unroll
                for (int m = 0; m < 4; ++m) { const int row = row0 + ai * HALF + m * 16, pos = row & 4095;
                    f32x4 cs[2], sn[2];
                    if (wc == 0) { const float* ct = cosT + pos * 16 + 8 * (fq & 1); const float* stp = sinT + pos * 16 + 8 * (fq & 1);
                        cs[0] = *(const f32x4*)ct; cs[1] = *(const f32x4*)(ct + 4); sn[0] = *(const f32x4*)stp; sn[1] = *(const f32x4*)(stp + 4); }
#pragma unroll
                    for (int bj = 0; bj < 2; ++bj) { f32x4 v[2] = {acc[ai][bj][m][0], acc[ai][bj][m][1]};
                        if (wc == 0) {
#pragma unroll
                            for (int n = 0; n < 2; ++n)
#pragma unroll
                                for (int k = 0; k < 4; ++k) { const float own = v[n][k], oth = __shfl_xor(own, 32); v[n][k] = own * cs[n][k] + (fq < 2 ? -oth : oth) * sn[n][k]; } }
                        v[0] = v[0] * sc; v[1] = v[1] * sc;
                        *(u32x4*)(O + (size_t)row * ld + bj * HALF + c8) = pack8(v[0], v[1]); } }
        } else if (pn == 13) {
#pragma unroll
            for (int ai = 0; ai < 2; ++ai)
#pragma unroll
                for (int m = 0; m < 4; ++m) { const int row = row0 + ai * HALF + m * 16;
#pragma unroll
                    for (int bj = 0; bj < 2; ++bj) *(u32x4*)(Vb + (size_t)row * 256 + bj * HALF + c8) = pack8(acc[ai][bj][m][0], acc[ai][bj][m][1]); }
        } else {
            const int col = (pn - 14) * 128 + c8;
#pragma unroll
            for (int ai = 0; ai < 2; ++ai)
#pragma unroll
                for (int m = 0; m < 4; ++m) { const int row = row0 + ai * HALF + m * 16; f32x4 ra[2], sb[2];
#pragma unroll
                    for (int n = 0; n < 2; ++n)
#pragma unroll
                        for (int k = 0; k < 4; ++k) { const float gA = fminf(fmaxf(acc[ai][0][m][n][k], -30.f), 30.f), gB = fminf(fmaxf(acc[ai][1][m][n][k], -30.f), 30.f);
                            const float eA = __expf(-gA), eB = __expf(-gB); ra[n][k] = (1.f + eB) / (1.f + eA); sb[n][k] = 1.f / (1.f + eB); }
                    *(u32x4*)(RA + (size_t)row * 2048 + col) = pack8(ra[0], ra[1]); *(u32x4*)(SB + (size_t)row * 2048 + col) = pack8(sb[0], sb[1]); }
        }
    }
};

struct EpiConvGlu {
    static constexpr bool PERM = true, AFTER_DRAIN = false, HALO = true;
    bf16_t* H; const float* cw; const float* cb;
    __device__ __forceinline__ static float ror1(float v) { return __int_as_float(__builtin_amdgcn_update_dpp(0, __float_as_int(v), 0x121, 0xf, 0xf, false)); }
    __device__ __forceinline__ static float rol1(float v) { return __int_as_float(__builtin_amdgcn_update_dpp(0, __float_as_int(v), 0x12F, 0xf, 0xf, false)); }
    __device__ __forceinline__ void operator()(const f32x4 (&acc)[2][2][4][2], const Unit& u, int wr, int wc, int fr, int fq) const {
        const int gbase = 252 * u.pm - 1 + 126 * wr, colo = 128 * u.pn + 32 * wc + 8 * fq;
#pragma unroll
        for (int n = 0; n < 2; ++n) {
            f32x4 w0[2], w1[2], w2[2], bb[2];
#pragma unroll
            for (int bj = 0; bj < 2; ++bj) { const int oc = colo + 4 * n + bj * 5632;
                w0[bj] = *(const f32x4*)(cw + oc); w1[bj] = *(const f32x4*)(cw + 11264 + oc); w2[bj] = *(const f32x4*)(cw + 2 * 11264 + oc); bb[bj] = *(const f32x4*)(cb + oc); }
#pragma unroll
            for (int q = 0; q < 8; ++q) { const int ai = q >> 2, m = q & 3, g = 16 * q + fr, grow = gbase + g, t = grow & 4095;
                f32x4 cv[2];
#pragma unroll
                for (int bj = 0; bj < 2; ++bj) { const f32x4 cur = acc[ai][bj][m][n]; f32x4 prv, nxt;
#pragma unroll
                    for (int k = 0; k < 4; ++k) {
                        float p = ror1(cur[k]); if (q > 0) { const float pb = ror1(acc[(q - 1) >> 2][bj][(q - 1) & 3][n][k]); p = fr == 0 ? pb : p; }
                        float x = rol1(cur[k]); if (q < 7) { const float xb = rol1(acc[(q + 1) >> 2][bj][(q + 1) & 3][n][k]); x = fr == 15 ? xb : x; }
                        prv[k] = t == 0 ? 0.f : p; nxt[k] = t == 4095 ? 0.f : x; }
                    cv[bj] = bb[bj] + w0[bj] * prv + w1[bj] * cur + w2[bj] * nxt; }
                f32x4 h;
#pragma unroll
                for (int k = 0; k < 4; ++k) h[k] = gelu_t(cv[0][k]) * cv[1][k];
                if (g >= 1 && g <= 126 && grow < 8192) { u32x2 w; w.x = cvt_pk_bf16(h[0], h[1]); w.y = cvt_pk_bf16(h[2], h[3]); *(u32x2*)(H + (size_t)grow * 5632 + colo + 4 * n) = w; } }
        }
    }
};


struct EpiBf16Plain {
    static constexpr bool PERM = true, AFTER_DRAIN = false, HALO = false;
    bf16_t* O; int ldc, pad;
    __device__ __forceinline__ void operator()(const f32x4 (&acc)[2][2][4][2], const Unit& u, int wr, int wc, int fr, int fq) const {
        const int row0 = u.pm * BM + wr * 64 + fr, col0 = u.pn * BM + wc * 32 + 8 * fq;
#pragma unroll
        for (int ai = 0; ai < 2; ++ai)
#pragma unroll
            for (int m = 0; m < 4; ++m) { bf16_t* rowp = O + (size_t)(row0 + ai * HALF + m * 16) * ldc + col0;
#pragma unroll
                for (int bj = 0; bj < 2; ++bj) { const f32x4 v0 = acc[ai][bj][m][0], v1 = acc[ai][bj][m][1];
                    u32x4 w; w.x = cvt_pk_bf16(v0[0], v0[1]); w.y = cvt_pk_bf16(v0[2], v0[3]); w.z = cvt_pk_bf16(v1[0], v1[1]); w.w = cvt_pk_bf16(v1[2], v1[3]);
                    *(u32x4*)(rowp + bj * HALF) = w; } }
    }
};
__device__ __forceinline__ float bfbits2f(unsigned short v) { return __uint_as_float(((unsigned)v) << 16); }
struct EpiF32 {
    static constexpr bool PERM = false, AFTER_DRAIN = false, HALO = false;
    float* O; const bf16_t* S; int ldc, lds_;
    __device__ __forceinline__ void operator()(const f32x4 (&acc)[2][2][4][2], const Unit& u, int wr, int wc, int fr, int fq) const {
        const int row0 = u.pm * BM + wr * 64 + fr, col0 = u.pn * BM + wc * 32 + 4 * fq;
#pragma unroll
        for (int ai = 0; ai < 2; ++ai)
#pragma unroll
            for (int m = 0; m < 4; ++m) { const size_t r = (size_t)(row0 + ai * HALF + m * 16);
#pragma unroll
                for (int bj = 0; bj < 2; ++bj)
#pragma unroll
                    for (int n = 0; n < 2; ++n) { f32x4 v = acc[ai][bj][m][n]; const int c = col0 + bj * HALF + n * 16;
                        if (S) { const u32x2 s = *(const u32x2*)(S + r * lds_ + c);
                            v[0] *= __uint_as_float(s.x << 16); v[1] *= __uint_as_float(s.x & 0xffff0000u); v[2] *= __uint_as_float(s.y << 16); v[3] *= __uint_as_float(s.y & 0xffff0000u); }
                        *(f32x4*)(O + r * ldc + c) = v; } }
    }
};
struct EpiMerge {
    static constexpr bool PERM = false, AFTER_DRAIN = false, HALO = false;
    bf16_t* O; const float* P; const bf16_t* S; int ldc, pad;
    __device__ __forceinline__ void operator()(const f32x4 (&acc)[2][2][4][2], const Unit& u, int wr, int wc, int fr, int fq) const {
        const int row0 = u.pm * BM + wr * 64 + fr, col0 = u.pn * BM + wc * 32 + 4 * fq;
#pragma unroll
        for (int ai = 0; ai < 2; ++ai)
#pragma unroll
            for (int m = 0; m < 4; ++m) { const size_t r = (size_t)(row0 + ai * HALF + m * 16);
#pragma unroll
                for (int bj = 0; bj < 2; ++bj)
#pragma unroll
                    for (int n = 0; n < 2; ++n) { const int c = col0 + bj * HALF + n * 16; f32x4 v = acc[ai][bj][m][n] + *(const f32x4*)(P + r * ldc + c);
                        const u32x2 s = *(const u32x2*)(S + r * ldc + c);
                        v[0] *= __uint_as_float(s.x << 16); v[1] *= __uint_as_float(s.x & 0xffff0000u); v[2] *= __uint_as_float(s.y << 16); v[3] *= __uint_as_float(s.y & 0xffff0000u);
                        u32x2 w; w.x = cvt_pk_bf16(v[0], v[1]); w.y = cvt_pk_bf16(v[2], v[3]); *(u32x2*)(O + r * ldc + c) = w; } }
    }
};

template <class Epi, class Sched, bool ALIGN_EPI = false, bool SP2 = false>
__device__ __forceinline__ void gemm_phase(PG8_LAS unsigned char* lds, const Gemm g, const Sched& S, const Epi& E) {
    int tid_ = threadIdx.x; asm volatile("" : "+v"(tid_));
    const int tid = tid_, wid = __builtin_amdgcn_readfirstlane(tid >> 6), lane = tid & 63, wr = wid >> 2, wc = wid & 3, fr = lane & 15, fq = lane >> 4;
    const int K = g.K, nt = K / BK;
    unsigned voffA[2], voffB[2];
#pragma unroll
    for (int i = 0; i < 2; ++i) { int R, C; stage_rc(tid * 16 + i * 8192, R, C); const int Rb = Epi::PERM ? ((R & ~31) + perm32(R & 31)) : R; const int Ra = Epi::HALO ? ((R >> 6) * 126 + (R & 63)) : R;
        voffA[i] = (unsigned)(Ra * g.lda + C) * 2u; voffB[i] = (unsigned)(Rb * g.ldb + C) * 2u; }
    const size_t kstep = (size_t)(BK * 2);
    const size_t hstepA = (size_t)(Epi::HALO ? 64 : HALF) * g.lda * 2, hstepB = (size_t)HALF * g.ldb * 2;
    const size_t tstepA = (size_t)(Epi::HALO ? 252 : BM) * g.lda * 2, tstepB = 2 * hstepB;
    const unsigned ldsw = (unsigned)wid * 1024u;
    const int aoff = lds_byte(wr * 64 + fr, fq * 8), boff = lds_byte(wc * 32 + fr, fq * 8);
#define PG8_SA(b, h) (((b) * 2 + (h)) * HTB)
#define PG8_SB(b, h) ((4 + (b) * 2 + (h)) * HTB)
#define PG8_STAGE(bufoff, gbase, voff) do { _Pragma("unroll") for (int _i = 0; _i < 2; ++_i) \
        __builtin_amdgcn_global_load_lds((const unsigned*)((const char*)(gbase) + (voff)[_i]), (PG8_LAS unsigned*)(lds + (bufoff) + ldsw + _i * 8192), 16, 0, 0); } while (0)
#define PG8_LDA(dst, b, h) do { _Pragma("unroll") for (int m = 0; m < 4; ++m) _Pragma("unroll") for (int k = 0; k < 2; ++k) dst[m][k] = *(const PG8_LAS bf16x8*)(lds + PG8_SA(b, h) + aoff + m * 2048 + k * 1024); } while (0)
#define PG8_LDB(dst, b, h) do { _Pragma("unroll") for (int n = 0; n < 2; ++n) _Pragma("unroll") for (int k = 0; k < 2; ++k) dst[n][k] = *(const PG8_LAS bf16x8*)(lds + PG8_SB(b, h) + boff + n * 2048 + k * 1024); } while (0)
#define PG8_MMA(ai, bj, At, Bt) do { __builtin_amdgcn_s_setprio(1); _Pragma("unroll") for (int m = 0; m < 4; ++m) _Pragma("unroll") for (int n = 0; n < 2; ++n) _Pragma("unroll") for (int k = 0; k < 2; ++k) \
        acc[ai][bj][m][n] = __builtin_amdgcn_mfma_f32_16x16x32_bf16(Bt[n][k], At[m][k], acc[ai][bj][m][n], 0, 0, 0); __builtin_amdgcn_s_setprio(0); } while (0)
#define PG8_WAIT_V(n) asm volatile("s_waitcnt vmcnt(" #n ")" ::: "memory")
#define PG8_WAIT_L(n) asm volatile("s_waitcnt lgkmcnt(" #n ")" ::: "memory")
#define PG8_BAR __builtin_amdgcn_s_barrier()
#define PG8_SCHED __builtin_amdgcn_sched_barrier(0)
    Unit cur, nxt; int ui = 0;
    if (!S.next(0, cur)) return;
    f32x4 acc[2][2][4][2];
#pragma unroll
    for (int a = 0; a < 2; ++a)
#pragma unroll
        for (int b = 0; b < 2; ++b)
#pragma unroll
            for (int m = 0; m < 4; ++m)
#pragma unroll
                for (int n = 0; n < 2; ++n) acc[a][b][m][n] = (f32x4){0.f, 0.f, 0.f, 0.f};
    bf16x8 At[4][2], B0[2][2], B1[2][2];
    const char* cA = (const char*)g.A + (size_t)cur.pm * tstepA; const char* cB = (const char*)g.Bt + (size_t)cur.pn * tstepB;
    S.a_ready(cur);
    if constexpr (SP2) {
        PG8_STAGE(PG8_SB(0, 0), cB, voffB); PG8_STAGE(PG8_SB(0, 1), cB + hstepB, voffB); PG8_STAGE(PG8_SA(0, 0), cA, voffA); PG8_STAGE(PG8_SA(0, 1), cA + hstepA, voffA);
        if (wr == 1) PG8_BAR;
        PG8_WAIT_V(2); PG8_BAR;
        PG8_STAGE(PG8_SB(1, 0), cB + kstep, voffB); PG8_STAGE(PG8_SA(1, 0), cA + kstep, voffA); PG8_STAGE(PG8_SB(1, 1), cB + hstepB + kstep, voffB);
        PG8_WAIT_V(6); PG8_BAR;
    } else {
        PG8_STAGE(PG8_SB(0, 0), cB, voffB); PG8_STAGE(PG8_SA(0, 0), cA, voffA); PG8_STAGE(PG8_SB(0, 1), cB + hstepB, voffB); PG8_STAGE(PG8_SA(0, 1), cA + hstepA, voffA);
        if (wr == 1) PG8_BAR;
        PG8_WAIT_V(4); PG8_BAR;
        PG8_STAGE(PG8_SB(1, 0), cB + kstep, voffB); PG8_STAGE(PG8_SA(1, 0), cA + kstep, voffA); PG8_STAGE(PG8_SB(1, 1), cB + hstepB + kstep, voffB);
        PG8_WAIT_V(6); PG8_BAR;
    }
    for (;;) {
        const bool has_next = S.next(ui + 1, nxt);
        const char* nA = has_next ? (const char*)g.A + (size_t)nxt.pm * tstepA : cA; const char* nB = has_next ? (const char*)g.Bt + (size_t)nxt.pn * tstepB : cB;
        for (int t = 0; t < nt; t += 2) {
            const bool last = (t == nt - 2);
            const char* a1 = cA + (size_t)(t + 1) * kstep;
            const char* a2 = last ? nA : cA + (size_t)(t + 2) * kstep; const char* b2 = last ? nB : cB + (size_t)(t + 2) * kstep;
            const char* a3 = a2 + kstep; const char* b3 = b2 + kstep;
            if (last && has_next) S.a_ready(nxt);
            if constexpr (SP2) {
            PG8_LDB(B0, 0, 0); PG8_LDB(B1, 0, 1); PG8_SCHED; PG8_LDA(At, 0, 0); PG8_STAGE(PG8_SA(1, 1), a1 + hstepA, voffA);
            PG8_WAIT_V(8); PG8_WAIT_L(0); PG8_BAR; PG8_MMA(0, 0, At, B0); PG8_MMA(0, 1, At, B1); PG8_BAR; PG8_SCHED;
            PG8_LDA(At, 0, 1); PG8_STAGE(PG8_SB(0, 0), b2, voffB); PG8_STAGE(PG8_SB(0, 1), b2 + hstepB, voffB); PG8_STAGE(PG8_SA(0, 0), a2, voffA);
            PG8_WAIT_V(8); PG8_WAIT_L(0); PG8_BAR; PG8_MMA(1, 0, At, B0); PG8_MMA(1, 1, At, B1); PG8_BAR; PG8_SCHED;
            PG8_LDB(B0, 1, 0); PG8_LDB(B1, 1, 1); PG8_SCHED; PG8_LDA(At, 1, 0); PG8_STAGE(PG8_SA(0, 1), a2 + hstepA, voffA);
            PG8_WAIT_V(8); PG8_WAIT_L(0); PG8_BAR; PG8_MMA(0, 0, At, B0); PG8_MMA(0, 1, At, B1); PG8_BAR; PG8_SCHED;
            PG8_LDA(At, 1, 1); PG8_STAGE(PG8_SB(1, 0), b3, voffB); PG8_STAGE(PG8_SB(1, 1), b3 + hstepB, voffB); PG8_STAGE(PG8_SA(1, 0), a3, voffA);
            PG8_WAIT_V(8); PG8_WAIT_L(0); PG8_BAR; PG8_MMA(1, 0, At, B0); PG8_MMA(1, 1, At, B1); PG8_BAR; PG8_SCHED;
            } else {
            PG8_LDB(B0, 0, 0); PG8_SCHED; PG8_LDA(At, 0, 0); PG8_STAGE(PG8_SA(1, 1), a1 + hstepA, voffA);
            PG8_WAIT_L(8); PG8_BAR; PG8_WAIT_L(0); PG8_MMA(0, 0, At, B0); PG8_BAR; PG8_SCHED;
            PG8_LDB(B1, 0, 1); PG8_STAGE(PG8_SB(0, 0), b2, voffB);
            PG8_BAR; PG8_WAIT_L(0); PG8_MMA(0, 1, At, B1); PG8_BAR;
            PG8_LDA(At, 0, 1); PG8_STAGE(PG8_SA(0, 0), a2, voffA);
            PG8_BAR; PG8_WAIT_L(0); PG8_MMA(1, 0, At, B0); PG8_BAR; PG8_SCHED;
            PG8_STAGE(PG8_SB(0, 1), b2 + hstepB, voffB);
            PG8_WAIT_V(6); PG8_BAR; PG8_MMA(1, 1, At, B1); PG8_BAR;
            PG8_LDB(B0, 1, 0); PG8_SCHED; PG8_LDA(At, 1, 0); PG8_STAGE(PG8_SA(0, 1), a2 + hstepA, voffA);
            PG8_WAIT_L(8); PG8_BAR; PG8_WAIT_L(0); PG8_MMA(0, 0, At, B0); PG8_BAR; PG8_SCHED;
            PG8_LDB(B1, 1, 1); PG8_STAGE(PG8_SB(1, 0), b3, voffB);
            PG8_BAR; PG8_WAIT_L(0); PG8_MMA(0, 1, At, B1); PG8_BAR;
            PG8_LDA(At, 1, 1); PG8_STAGE(PG8_SA(1, 0), a3, voffA);
            PG8_BAR; PG8_WAIT_L(0); PG8_MMA(1, 0, At, B0); PG8_BAR; PG8_SCHED;
            PG8_STAGE(PG8_SB(1, 1), b3 + hstepB, voffB);
            PG8_WAIT_V(6); PG8_BAR; PG8_MMA(1, 1, At, B1); PG8_BAR;
            }
        }
        if constexpr (ALIGN_EPI) { if (wr == 0) PG8_BAR; }
        if constexpr (!Epi::AFTER_DRAIN) { E(acc, cur, wr, wc, fr, fq); S.done(cur); }
        if (!has_next) break;
#pragma unroll
        for (int a = 0; a < 2; ++a)
#pragma unroll
            for (int b = 0; b < 2; ++b)
#pragma unroll
                for (int m = 0; m < 4; ++m)
#pragma unroll
                    for (int n = 0; n < 2; ++n) acc[a][b][m][n] = (f32x4){0.f, 0.f, 0.f, 0.f};
        cur = nxt; cA = nA; cB = nB; ++ui;
        if constexpr (ALIGN_EPI) { if (wr == 1) PG8_BAR; }
    }
    PG8_WAIT_V(0);
    if constexpr (!ALIGN_EPI) { if (wr == 0) PG8_BAR; }
    PG8_BAR;
    if constexpr (Epi::AFTER_DRAIN) { E.fused(acc, cur, wr, wc, fr, fq, lds, wid, lane); S.done(cur); }
#undef PG8_SA
#undef PG8_SB
#undef PG8_STAGE
#undef PG8_LDA
#undef PG8_LDB
#undef PG8_MMA
#undef PG8_WAIT_V
#undef PG8_WAIT_L
#undef PG8_BAR
#undef PG8_SCHED
}
}

typedef unsigned short bf16_t;
constexpr int DM = 2048, NB = 2, SEQ = 4096, MTOK = NB * SEQ;
constexpr int SGW_ = 1024, QW = 1024, KVW = 256, INW = 7680, DFF = 5632, UPW = 2 * DFF;
constexpr float EPS = 1e-6f;
constexpr float LOG2E = 1.4426950408889634f;
constexpr float QSCALE = 0.08838834764831845f * 1.4426950408889634f;
constexpr size_t MiB = 1u << 20;
constexpr size_t WS_CTL = 0;
constexpr size_t WS_ROPE = 1 * MiB;
constexpr size_t WS_STATS = 1 * MiB + 512 * 1024;
constexpr size_t WS_XBUF = 2 * MiB;
constexpr size_t WS_WIN = 4 * MiB, WS_WAB = 34 * MiB, WS_WO = 42 * MiB, WS_WUP = 50 * MiB, WS_WDN = 94 * MiB;
constexpr size_t WS_HF = 4 * MiB + 8192;
constexpr size_t WS_XN = 117 * MiB, WS_MG = 117 * MiB;
constexpr size_t WS_GU = 149 * MiB, WS_GV = 165 * MiB, WS_Q = 181 * MiB, WS_K = 197 * MiB, WS_V = 201 * MiB;
constexpr size_t WS_RA = 213 * MiB, WS_SB = 245 * MiB, WS_AB = 277 * MiB;
constexpr size_t WS_P1 = 149 * MiB;
constexpr size_t WS_Y = 213 * MiB;
constexpr size_t WS_H = 117 * MiB;
constexpr size_t WS_U = 205 * MiB, WS_F = 205 * MiB;
constexpr size_t WS_END = 309 * MiB;

#define DEV __device__ __forceinline__
DEV float bf2f(bf16_t v) { return __uint_as_float(((unsigned)v) << 16); }
DEV bf16_t f2bf(float f) { unsigned u = __float_as_uint(f); return (bf16_t)((u + 0x7fffu + ((u >> 16) & 1u)) >> 16); }
DEV unsigned pk2(float lo, float hi) { return (unsigned)f2bf(lo) | ((unsigned)f2bf(hi) << 16); }
DEV float gelu_tanh(float x) { const float u = 0.7978845608028654f * (x + 0.044715f * x * x * x); return x / (1.f + __expf(-2.f * u)); }
DEV float sigmoid_f(float g) { return 1.f / (1.f + __expf(-g)); }
DEV float wave_sum(float v) {
#pragma unroll
    for (int o = 1; o < 64; o <<= 1) v += __shfl_xor(v, o);
    return v;
}
DEV int colmap(int mode, int n) {
    if (mode == 1) { if (n < 3584) return n; const int j = (n - 3584) >> 8, c = (n - 3584) & 255; return c < 128 ? 3584 + 128 * j + c : 3584 + 2048 + 128 * j + (c - 128); }
    if (mode == 2) { const int j = n >> 8, c = n & 255; return c < 128 ? 128 * j + c : DFF + 128 * j + (c - 128); }
    return n;
}
#define LAS __attribute__((address_space(3)))
#define XB_TMO      128
#define XB_XCNT(j)  (256  + 64 * (j))
#define XB_XSUB(j)  (1280 + 64 * (j))
#define XB_XGEN(j)  (2304 + 64 * (j))
#define XB_TOP      3328
#define XB_TOPGEN   3392
#define XCD_BAR_WORDS 3456
#define XB_SPIN_CAP (1u << 18)

__device__ __forceinline__ unsigned xb_ld(unsigned* p)              { return __hip_atomic_load(p, __ATOMIC_RELAXED, __HIP_MEMORY_SCOPE_AGENT); }
__device__ __forceinline__ unsigned xb_add(unsigned* p, unsigned v) { return __hip_atomic_fetch_add(p, v, __ATOMIC_RELAXED, __HIP_MEMORY_SCOPE_AGENT); }
__device__ __forceinline__ unsigned xb_xcc_id() { return (unsigned)__builtin_amdgcn_s_getreg((3 << 11) | 20) & 0xFu; }
#define XB_SPIN(cond, bar) do { unsigned _sp = 0; while (cond) { __builtin_amdgcn_s_sleep(1); \
    if ((++_sp & 255u) == 0u) { if (xb_ld(&(bar)[XB_TMO])) break; if (_sp > XB_SPIN_CAP) { atomicAdd(&(bar)[XB_TMO], 1u); break; } } } } while (0)

struct XcdBarrier {
    unsigned* bar; unsigned x;
    volatile LAS unsigned* st;
};

__device__ __forceinline__ XcdBarrier xcd_barrier_post(unsigned* bar, volatile LAS unsigned* st) {
    XcdBarrier b; b.bar = bar; b.x = xb_xcc_id(); b.st = st;
    if (threadIdx.x == 0) (void)xb_add(&bar[XB_XCNT(b.x)], 1u);
    return b;
}
__device__ __forceinline__ void xcd_barrier_complete(unsigned* bar, unsigned x, unsigned& nloc, unsigned& nx) {
    const unsigned G = gridDim.x * gridDim.y * gridDim.z;
    unsigned sum, cnt, mine, sp = 0u;
    for (;;) {
        sum = 0u; cnt = 0u; mine = 0u;
#pragma unroll
        for (unsigned j = 0; j < 16; ++j) { const unsigned c = xb_ld(&bar[XB_XCNT(j)]); sum += c; cnt += (c > 0u) ? 1u : 0u; mine = (j == x) ? c : mine; }
        if (sum == G) break;
        __builtin_amdgcn_s_sleep(1);
        if ((++sp & 255u) == 0u) { if (xb_ld(&bar[XB_TMO])) break; if (sp > XB_SPIN_CAP) { atomicAdd(&bar[XB_TMO], 1u); break; } }
    }
    nloc = mine > 0u ? mine : 1u; nx = cnt > 0u ? cnt : 1u;
}

__device__ __forceinline__ void xcd_barrier(const XcdBarrier& b) {
    asm volatile("s_waitcnt vmcnt(0)" ::: "memory");
    __syncthreads();
    if (threadIdx.x == 0) {
        unsigned* bar = b.bar;
        __builtin_amdgcn_s_waitcnt(0);
        unsigned nloc = b.st[0], nx = b.st[1];
        if (nloc == 0u) { xcd_barrier_complete(bar, b.x, nloc, nx); b.st[0] = nloc; b.st[1] = nx; }
        const unsigned old = xb_add(&bar[XB_XSUB(b.x)], 1u);
        const unsigned gen = old / nloc;
        if (old + 1u == (gen + 1u) * nloc) {
            __builtin_amdgcn_fence(__ATOMIC_RELEASE, "agent");
            asm volatile("s_waitcnt vmcnt(0)" ::: "memory");
            const unsigned og = xb_add(&bar[XB_TOP], 1u);
            const unsigned tg = og / nx;
            if (og + 1u == (tg + 1u) * nx) xb_add(&bar[XB_TOPGEN], 1u);
            else XB_SPIN(xb_ld(&bar[XB_TOPGEN]) == tg, bar);
            __builtin_amdgcn_fence(__ATOMIC_ACQUIRE, "agent");
            xb_add(&bar[XB_XGEN(b.x)], 1u);
            asm volatile("s_waitcnt vmcnt(0)" ::: "memory");
        } else {
            XB_SPIN(xb_ld(&bar[XB_XGEN(b.x)]) == gen, bar);
            __builtin_amdgcn_fence(__ATOMIC_ACQUIRE, "agent");
            asm volatile("s_waitcnt vmcnt(0)" ::: "memory");
        }
    }
    __syncthreads();
}
constexpr int NWAVES = 8;
constexpr int RING_BYTES = 131072, LDSCTL_OFF = RING_BYTES, MISC_OFF = LDSCTL_OFF + 320, LDS_BYTES = 147456;
constexpr int CW_BAR = 4096;
constexpr size_t CTL_ZERO_BYTES = 65536;
struct Ctx { int lane, wave, tid, gw, NGW, gtid, NGT; unsigned char* lds; };

DEV void p_transpose(const Ctx& c, const float* __restrict__ W, bf16_t* WT, int K, int N, int ndst, int ldk, int koff, int mode) {
    float* scr = (float*)(c.lds + c.wave * (64 * 33 * 4)); const int lane = c.lane;
    const int nblk = ndst / 32, nitems = (K / 64) * nblk;
    for (int item = c.gw; item < nitems; item += c.NGW) {
        const int kb = item / nblk, nb = item % nblk, k0 = 64 * kb, n0 = 32 * nb, s0 = colmap(mode, n0);
#pragma unroll 8
        for (int i = 0; i < 32; ++i) { const int kk = 2 * i + (lane >> 5); scr[kk * 33 + (lane & 31)] = W[(size_t)(k0 + kk) * N + s0 + (lane & 31)]; }
        __builtin_amdgcn_wave_barrier(); asm volatile("s_waitcnt lgkmcnt(0)" ::: "memory");
        const int cc = lane & 7;
#pragma unroll
        for (int j = 0; j < 4; ++j) { const int n = (lane >> 3) + 8 * j; const float* s = scr + (8 * cc) * 33 + n;
            uint4 o; o.x = pk2(s[0 * 33], s[1 * 33]); o.y = pk2(s[2 * 33], s[3 * 33]); o.z = pk2(s[4 * 33], s[5 * 33]); o.w = pk2(s[6 * 33], s[7 * 33]);
            *(uint4*)(WT + (size_t)(n0 + n) * ldk + koff + k0 + 8 * cc) = o; }
        __builtin_amdgcn_wave_barrier(); asm volatile("s_waitcnt lgkmcnt(0)" ::: "memory");
    }
}
DEV void p_rms_in(const Ctx& c, const float* __restrict__ x, const float* __restrict__ g, bf16_t* out) {
    const int lane = c.lane;
    for (int row = c.gw; row < MTOK; row += c.NGW) {
        const float4* xr = (const float4*)(x + (size_t)row * DM); const float4* gr = (const float4*)g;
        float4 v[8]; float ss = 0.f;
#pragma unroll
        for (int j = 0; j < 8; ++j) { v[j] = xr[lane + 64 * j]; ss += v[j].x * v[j].x + v[j].y * v[j].y + v[j].z * v[j].z + v[j].w * v[j].w; }
        const float r = rsqrtf(wave_sum(ss) * (1.f / DM) + EPS);
        uint2* o = (uint2*)(out + (size_t)row * DM);
#pragma unroll
        for (int j = 0; j < 8; ++j) { const float4 gg = gr[lane + 64 * j]; uint2 w; w.x = pk2(v[j].x * r * gg.x, v[j].y * r * gg.y); w.y = pk2(v[j].z * r * gg.z, v[j].w * r * gg.w); o[lane + 64 * j] = w; }
    }
}
__device__ const float INV_FREQ[16] = {1.000000000e+00f, 4.403665960e-01f, 1.939227432e-01f, 8.539710194e-02f, 3.760603070e-02f, 1.656043902e-02f, 7.292664610e-03f, 3.211445874e-03f,
                                       1.414213562e-03f, 6.227723788e-04f, 2.742481884e-04f, 1.207697351e-04f, 5.318296098e-05f, 2.341999971e-05f, 1.031338616e-05f, 4.541670478e-06f};
DEV void p_rope_table(const Ctx& c, float* cosT, float* sinT) {
    for (int idx = c.gtid; idx < SEQ * 16; idx += c.NGT) { const int pos = idx >> 4, i = idx & 15; const float ang = (float)pos * INV_FREQ[i];
        cosT[idx] = (float)cos((double)ang); sinT[idx] = (float)sin((double)ang); }
}
DEV void p_sg_naive(const Ctx& c, const bf16_t* GU, const bf16_t* GV, const float* stats, const float* __restrict__ ln_g, const float* __restrict__ ln_b, const float* __restrict__ sgw, const float* __restrict__ sgb, bf16_t* AB) {
    for (int idx = c.gtid; idx < MTOK * 1024; idx += c.NGT) {
        const int col = idx & 1023, row = idx >> 10, g = col >> 7, t = row & 127, cb = row - t;
        const float* w = sgw + (size_t)(g * 128 + t) * 128; float acc = 0.f; const float lg = ln_g[col], lb = ln_b[col];
        for (int s = 0; s < 128; ++s) { const float mean = stats[2 * (cb + s)] * (1.f / 1024.f), var = stats[2 * (cb + s) + 1] * (1.f / 1024.f) - mean * mean, rstd = rsqrtf(var + EPS);
            acc += w[s] * ((bf2f(GV[(size_t)(cb + s) * 1024 + col]) - mean) * rstd * lg + lb); }
        acc += sgb[g * 128 + t];
        AB[(size_t)row * 2048 + col] = f2bf(bf2f(GU[(size_t)row * 1024 + col]) * acc);
    }
}
DEV void p_attn_naive(const Ctx& c, const bf16_t* Q, const bf16_t* Kb, const bf16_t* Vb, const float* __restrict__ sink, bf16_t* AB) {
    const int lane = c.lane;
    for (int idx = c.gw; idx < MTOK * 8; idx += c.NGW) {
        const int row = idx >> 3, h = idx & 7, kvh = h >> 2, b = row / SEQ, pos = row % SEQ;
        const unsigned qq = *(const unsigned*)(Q + (size_t)row * 1024 + h * 128 + 2 * lane); const float q0 = __uint_as_float(qq << 16), q1 = __uint_as_float(qq & 0xffff0000u);
        float m = sink[h] * LOG2E, l = 1.f, o0 = 0.f, o1 = 0.f;
        const int klo = pos - 128 < 0 ? 0 : pos - 128, khi = pos + 128 > SEQ - 1 ? SEQ - 1 : pos + 128;
        for (int kp = klo; kp <= khi; ++kp) { const size_t kr = (size_t)(b * SEQ + kp) * 256 + kvh * 128 + 2 * lane;
            const unsigned kk = *(const unsigned*)(Kb + kr), vv = *(const unsigned*)(Vb + kr);
            const float s = wave_sum(q0 * __uint_as_float(kk << 16) + q1 * __uint_as_float(kk & 0xffff0000u));
            const float mn = fmaxf(m, s), a = exp2f(m - mn), p = exp2f(s - mn);
            l = l * a + p; o0 = o0 * a + p * __uint_as_float(vv << 16); o1 = o1 * a + p * __uint_as_float(vv & 0xffff0000u); m = mn; }
        const float il = 1.f / l;
        *(unsigned*)(AB + (size_t)row * 2048 + 1024 + h * 128 + 2 * lane) = pk2(o0 * il, o1 * il);
    }
}
DEV void p_post4(const Ctx& c, const float* Y, const float* __restrict__ x, const float* __restrict__ g1, const float* __restrict__ g2, float* out, bf16_t* HF) {
    const int lane = c.lane;
    for (int row = c.gw; row < MTOK; row += c.NGW) {
        const float4* yr = (const float4*)(Y + (size_t)row * DM); const float4* xr = (const float4*)(x + (size_t)row * DM);
        float4 v[8]; float ss = 0.f;
#pragma unroll
        for (int j = 0; j < 8; ++j) { v[j] = yr[lane + 64 * j]; ss += v[j].x * v[j].x + v[j].y * v[j].y + v[j].z * v[j].z + v[j].w * v[j].w; }
        const float r1 = rsqrtf(wave_sum(ss) * (1.f / DM) + EPS); float s2 = 0.f;
#pragma unroll
        for (int j = 0; j < 8; ++j) { const float4 gg = ((const float4*)g1)[lane + 64 * j], xx = xr[lane + 64 * j];
            v[j].x = xx.x + v[j].x * r1 * gg.x; v[j].y = xx.y + v[j].y * r1 * gg.y; v[j].z = xx.z + v[j].z * r1 * gg.z; v[j].w = xx.w + v[j].w * r1 * gg.w;
            s2 += v[j].x * v[j].x + v[j].y * v[j].y + v[j].z * v[j].z + v[j].w * v[j].w; ((float4*)(out + (size_t)row * DM))[lane + 64 * j] = v[j]; }
        const float r2 = rsqrtf(wave_sum(s2) * (1.f / DM) + EPS);
#pragma unroll
        for (int j = 0; j < 8; ++j) { const float4 gg = ((const float4*)g2)[lane + 64 * j]; uint2 w; w.x = pk2(v[j].x * r2 * gg.x, v[j].y * r2 * gg.y); w.y = pk2(v[j].z * r2 * gg.z, v[j].w * r2 * gg.w);
            ((uint2*)(HF + (size_t)row * DM))[lane + 64 * j] = w; }
    }
}
DEV void p_conv_naive(const Ctx& c, const bf16_t* U, const float* __restrict__ cw, const float* __restrict__ cb, bf16_t* H) {
    for (int idx = c.gtid; idx < SEQ * DFF; idx += c.NGT) {
        const int cc = idx % DFF, t = idx / DFF, j = cc >> 7, ci = cc & 127, gcol = 256 * j + ci, vcol = gcol + 128, og = cc, ov = DFF + cc;
        float cg = cb[og], cv = cb[ov];
#pragma unroll
        for (int jj = 0; jj < 3; ++jj) { const int tt = t + jj - 1; if (tt >= 0 && tt < SEQ) { cg += cw[jj * UPW + og] * bf2f(U[(size_t)tt * UPW + gcol]); cv += cw[jj * UPW + ov] * bf2f(U[(size_t)tt * UPW + vcol]); } }
        H[(size_t)t * DFF + cc] = f2bf(gelu_tanh(cg) * cv);
    }
}
DEV void p_post6(const Ctx& c, const float* F, const float* __restrict__ g, float* out) {
    const int lane = c.lane;
    for (int row = c.gw; row < MTOK; row += c.NGW) {
        const float4* fr = (const float4*)(F + (size_t)row * DM); float4* orow = (float4*)(out + (size_t)row * DM);
        float4 v[8]; float ss = 0.f;
#pragma unroll
        for (int j = 0; j < 8; ++j) { v[j] = fr[lane + 64 * j]; ss += v[j].x * v[j].x + v[j].y * v[j].y + v[j].z * v[j].z + v[j].w * v[j].w; }
        const float r = rsqrtf(wave_sum(ss) * (1.f / DM) + EPS);
#pragma unroll
        for (int j = 0; j < 8; ++j) { const float4 gg = ((const float4*)g)[lane + 64 * j]; float4 xx = orow[lane + 64 * j];
            xx.x += v[j].x * r * gg.x; xx.y += v[j].y * r * gg.y; xx.z += v[j].z * r * gg.z; xx.w += v[j].w * r * gg.w; orow[lane + 64 * j] = xx; }
    }
}

namespace att {
typedef short bf16x8 __attribute__((ext_vector_type(8)));
typedef short s16x4 __attribute__((ext_vector_type(4)));
typedef float f32x16 __attribute__((ext_vector_type(16)));
typedef float f32x4 __attribute__((ext_vector_type(4)));
typedef unsigned u32x4 __attribute__((ext_vector_type(4)));
constexpr int KVBLK = 64, SHM_V = KVBLK * 128 * 2, SHM_K = KVBLK * 128 * 2;
constexpr int LDS_V = 0, LDS_K = 2 * SHM_V, LDS_WS = 2 * SHM_V + 2 * SHM_K;
#define KSWZ(row, colB) ((row) * 256 + ((colB) ^ (((row) & 7) << 4)))
#define SBAR() __builtin_amdgcn_sched_barrier(0)
DEV int v_st(int k, int c) { const int kk = (k & ~0xC) | ((k & 4) << 1) | ((k & 8) >> 1); return ((kk >> 3) * 4 + (c >> 5)) * 512 + ((kk & 7) * 32 + (c & 31)) * 2; }
DEV int v_rd_base(int lane) { return ((lane & 3) << 3) | (((lane >> 2) & 3) << 6) | (((lane >> 4) & 1) << 5) | (((lane >> 5) & 1) << 8); }
constexpr int v_rd_off(int d0, int ks, int half) { return d0 * 512 + ks * 4096 + half * 2048; }
DEV int crow(int r, int hi) { return (r & 3) + 8 * (r >> 2) + 4 * hi; }
DEV unsigned cvtpk(float lo, float hi) { unsigned r; asm volatile("v_cvt_pk_bf16_f32 %0, %1, %2" : "=v"(r) : "v"(lo), "v"(hi)); return r; }
DEV bf16x8 pack8(f32x4 a, f32x4 b) { u32x4 w = {cvtpk(a[0], a[1]), cvtpk(a[2], a[3]), cvtpk(b[0], b[1]), cvtpk(b[2], b[3])}; return *reinterpret_cast<bf16x8*>(&w); }

template <int KB> DEV void qkt(f32x16& p0, f32x16& p1, const char* K_lds, int r32, int hi, const bf16x8* qr) {
    p0 = f32x16{}; p1 = f32x16{};
    const char* kb[4];
#pragma unroll
    for (int dd = 0; dd < 4; ++dd) kb[dd] = K_lds + KB * SHM_K + KSWZ(r32, (dd * 16 + hi * 8) * 2);
#pragma unroll
    for (int d0 = 0; d0 < 8; ++d0) { const char* a = kb[d0 & 3] + (d0 >> 2) * 128;
        const bf16x8 b0 = *reinterpret_cast<const bf16x8*>(a);
        const bf16x8 b1 = *reinterpret_cast<const bf16x8*>(a + 32 * 256);
        p0 = __builtin_amdgcn_mfma_f32_32x32x16_bf16(b0, qr[d0], p0, 0, 0, 0);
        p1 = __builtin_amdgcn_mfma_f32_32x32x16_bf16(b1, qr[d0], p1, 0, 0, 0); }
}
#define TRRD(dst, off) asm volatile("ds_read_b64_tr_b16 %0, %1 offset:%2" : "=&v"(dst) : "v"(vb0), "i"(off) : "memory")
#define PV_D0(OI, d0, VB) do { s16x4 l0, l1, l2, l3, h0, h1, h2, h3; constexpr int b_ = (VB) * SHM_V + v_rd_off(d0, 0, 0); \
        TRRD(l0, b_); TRRD(h0, b_ + 2048); TRRD(l1, b_ + 4096); TRRD(h1, b_ + 6144); TRRD(l2, b_ + 8192); TRRD(h2, b_ + 10240); TRRD(l3, b_ + 12288); TRRD(h3, b_ + 14336); \
        asm volatile("s_waitcnt lgkmcnt(0)" ::: "memory"); SBAR(); \
        o[OI] = __builtin_amdgcn_mfma_f32_32x32x16_bf16(pa0, (bf16x8){l0[0], l0[1], l0[2], l0[3], h0[0], h0[1], h0[2], h0[3]}, o[OI], 0, 0, 0); \
        o[OI] = __builtin_amdgcn_mfma_f32_32x32x16_bf16(pa1, (bf16x8){l1[0], l1[1], l1[2], l1[3], h1[0], h1[1], h1[2], h1[3]}, o[OI], 0, 0, 0); \
        o[OI] = __builtin_amdgcn_mfma_f32_32x32x16_bf16(pa2, (bf16x8){l2[0], l2[1], l2[2], l2[3], h2[0], h2[1], h2[2], h2[3]}, o[OI], 0, 0, 0); \
        o[OI] = __builtin_amdgcn_mfma_f32_32x32x16_bf16(pa3, (bf16x8){l3[0], l3[1], l3[2], l3[3], h3[0], h3[1], h3[2], h3[3]}, o[OI], 0, 0, 0); } while (0)
template <int VB> DEV void pv_tile(f32x16* o, int vb0, bf16x8 pa0, bf16x8 pa1, bf16x8 pa2, bf16x8 pa3) { PV_D0(0, 0, VB); PV_D0(1, 1, VB); PV_D0(2, 2, VB); PV_D0(3, 3, VB); }
template <int VB> DEV void pv_half(f32x16* o, int vb0, bf16x8 pa0, bf16x8 pa1, bf16x8 pa2, bf16x8 pa3) { PV_D0(0, 0, VB); PV_D0(1, 1, VB); }

DEV void attn_unit(unsigned char* lds, const bf16_t* Qg, const bf16_t* Kg, const bf16_t* Vg, const float* __restrict__ sink, bf16_t* AB, int b, int n, int hp) {
    int tid_ = threadIdx.x; asm volatile("" : "+v"(tid_));
    const int tid = tid_, wid = __builtin_amdgcn_readfirstlane(tid >> 6), lane = tid & 63, r32 = lane & 31, hi = lane >> 5;
    const int head = 2 * hp + (wid >> 2), kvh = hp >> 1, qpos = n * 128 + (wid & 3) * 32 + r32;
    char* V_lds = (char*)lds + LDS_V; char* K_lds = (char*)lds + LDS_K; float* ws = (float*)(lds + LDS_WS) + wid * 64; float* li_l = ws; float* al_l = ws + 32;
    bf16x8 qr[8];
#pragma unroll
    for (int d0 = 0; d0 < 8; ++d0) qr[d0] = *reinterpret_cast<const bf16x8*>(Qg + (size_t)(b * SEQ + qpos) * 1024 + head * 128 + d0 * 16 + hi * 8);
    float m_reg = sink[head] * LOG2E, l_reg = 1.f; f32x16 o[4] = {};
    const int sr = tid >> 4, sc = (tid & 15) * 8, vst0 = v_st(sr, sc), vst1 = v_st(32 + sr, sc), kws = KSWZ(sr, sc * 2);
    const int vb0 = (int)(uintptr_t)V_lds + v_rd_base(lane);
    const int jlo = n >= 1 ? 2 * n - 2 : 0, jhi = n <= 30 ? 2 * n + 4 : 64, NT = jhi - jlo;
    const bf16_t* Kh = Kg + (size_t)b * SEQ * 256 + kvh * 128 + sc; const bf16_t* Vh = Vg + (size_t)b * SEQ * 256 + kvh * 128 + sc;
    bf16x8 st_k0, st_k1, st_v0, st_v1;
#define SLOAD(k0) do { st_v0 = *reinterpret_cast<const bf16x8*>(Vh + (size_t)((k0) + sr) * 256); st_v1 = *reinterpret_cast<const bf16x8*>(Vh + (size_t)((k0) + 32 + sr) * 256); \
                       st_k0 = *reinterpret_cast<const bf16x8*>(Kh + (size_t)((k0) + sr) * 256); st_k1 = *reinterpret_cast<const bf16x8*>(Kh + (size_t)((k0) + 32 + sr) * 256); } while (0)
#define SWRITE(bf) do { *(bf16x8*)(V_lds + (bf) * SHM_V + vst0) = st_v0; *(bf16x8*)(V_lds + (bf) * SHM_V + vst1) = st_v1; \
                        *(bf16x8*)(K_lds + (bf) * SHM_K + kws) = st_k0; *(bf16x8*)(K_lds + (bf) * SHM_K + kws + 32 * 256) = st_k1; } while (0)
#define PK4(P, B_, OUT) do { unsigned a0 = cvtpk(P[B_ + 0], P[B_ + 1]), a1 = cvtpk(P[B_ + 2], P[B_ + 3]); unsigned b0 = cvtpk(P[B_ + 4], P[B_ + 5]), b1 = cvtpk(P[B_ + 6], P[B_ + 7]); \
        auto r0 = __builtin_amdgcn_permlane32_swap(a0, b0, false, false); auto r1 = __builtin_amdgcn_permlane32_swap(a1, b1, false, false); \
        u32x4 w = {r0[0], r1[0], r0[1], r1[1]}; OUT = *reinterpret_cast<bf16x8*>(&w); } while (0)
#define STEP(t, BUF, NXT) do { \
        if ((t) + 1 < NT) SLOAD((jlo + (t) + 1) * KVBLK); \
        f32x16 p0, p1; SBAR(); qkt<BUF>(p0, p1, K_lds, r32, hi, qr); \
        { const int dq = (jlo + (t)) * KVBLK + 4 * hi - qpos + 128; const float NEG = -__builtin_inff(); \
          _Pragma("unroll") for (int r = 0; r < 16; ++r) { const int cc = (r & 3) + 8 * (r >> 2); if ((unsigned)(dq + cc) > 256u) p0[r] = NEG; if ((unsigned)(dq + cc + 32) > 256u) p1[r] = NEG; } } \
        float pmax = p0[0]; _Pragma("unroll") for (int r = 1; r < 16; ++r) pmax = fmaxf(pmax, p0[r]); _Pragma("unroll") for (int r = 0; r < 16; ++r) pmax = fmaxf(pmax, p1[r]); \
        { auto rr = __builtin_amdgcn_permlane32_swap(__float_as_uint(pmax), __float_as_uint(pmax), false, false); pmax = fmaxf(__uint_as_float(rr[0]), __uint_as_float(rr[1])); } \
        float alpha = 1.f; \
        if (!__all(pmax - m_reg <= 8.f)) { const float mn = fmaxf(m_reg, pmax); alpha = __builtin_amdgcn_exp2f(m_reg - mn); m_reg = mn; } \
        _Pragma("unroll") for (int r = 0; r < 16; ++r) { p0[r] = __builtin_amdgcn_exp2f(p0[r] - m_reg); p1[r] = __builtin_amdgcn_exp2f(p1[r] - m_reg); } \
        float ps = 0.f; _Pragma("unroll") for (int r = 0; r < 16; ++r) ps += p0[r] + p1[r]; \
        { auto rr = __builtin_amdgcn_permlane32_swap(__float_as_uint(ps), __float_as_uint(ps), false, false); ps = __uint_as_float(rr[0]) + __uint_as_float(rr[1]); } \
        l_reg = l_reg * alpha + ps; \
        bf16x8 pa0, pa1, pa2, pa3; PK4(p0, 0, pa0); PK4(p0, 8, pa1); PK4(p1, 0, pa2); PK4(p1, 8, pa3); \
        if (__any(alpha < 1.f)) { if (hi == 0) al_l[r32] = alpha; asm volatile("s_waitcnt lgkmcnt(0)" ::: "memory"); \
            _Pragma("unroll") for (int d_ = 0; d_ < 4; ++d_) _Pragma("unroll") for (int r = 0; r < 16; ++r) o[d_][r] *= al_l[crow(r, hi)]; } \
        SBAR(); pv_tile<BUF>(o, vb0, pa0, pa1, pa2, pa3); \
        if ((t) + 1 < NT) SWRITE(NXT); \
        __syncthreads(); } while (0)
    SLOAD(jlo * KVBLK); SWRITE(0); __syncthreads();
    for (int t = 0; t < NT; t += 2) { STEP(t, 0, 1); STEP(t + 1, 1, 0); }
    if (hi == 0) li_l[r32] = l_reg; asm volatile("s_waitcnt lgkmcnt(0)" ::: "memory");
    bf16_t* Ow = AB + (size_t)(b * SEQ + n * 128 + (wid & 3) * 32) * 2048 + 1024 + head * 128;
#pragma unroll
    for (int r = 0; r < 16; ++r) { const int orow = crow(r, hi); const float rl = __builtin_amdgcn_rcpf(li_l[orow]);
#pragma unroll
        for (int d0 = 0; d0 < 4; ++d0) { const float v = o[d0][r] * rl; const float vn = __shfl_xor(v, 1);
            if ((r32 & 1) == 0) *(unsigned*)(Ow + (size_t)orow * 2048 + d0 * 32 + r32) = cvtpk(v, vn); } }
    __syncthreads();
#undef STEP
#undef SLOAD
#undef SWRITE
}

DEV void sg_unit(unsigned char* lds, const bf16_t* GU, const bf16_t* GV, const float* stats, const float* __restrict__ ln_g, const float* __restrict__ ln_b, const float* __restrict__ sgw, const float* __restrict__ sgb, bf16_t* AB, int ci, int g) {
    int tid_ = threadIdx.x; asm volatile("" : "+v"(tid_));
    const int tid = tid_, wid = __builtin_amdgcn_readfirstlane(tid >> 6), lane = tid & 63, r32 = lane & 31, hi = lane >> 5, tb = wid & 3, dh = wid >> 2;
    char* V_lds = (char*)lds + LDS_V; const int cb = ci * 128;
    const int sr = tid >> 4, sc = (tid & 15) * 8;
    { const f32x4 g0 = *(const f32x4*)(ln_g + g * 128 + sc), g1 = *(const f32x4*)(ln_g + g * 128 + sc + 4), b0 = *(const f32x4*)(ln_b + g * 128 + sc), b1 = *(const f32x4*)(ln_b + g * 128 + sc + 4);
#pragma unroll
      for (int q = 0; q < 4; ++q) { const int s = sr + 32 * q, row = cb + s;
          const float mean = stats[2 * row] * (1.f / 1024.f), var = stats[2 * row + 1] * (1.f / 1024.f) - mean * mean, rstd = rsqrtf(var + EPS);
          const u32x4 raw = *(const u32x4*)(GV + (size_t)row * 1024 + g * 128 + sc);
          f32x4 a, bb; a[0] = __uint_as_float(raw.x << 16); a[1] = __uint_as_float(raw.x & 0xffff0000u); a[2] = __uint_as_float(raw.y << 16); a[3] = __uint_as_float(raw.y & 0xffff0000u);
          bb[0] = __uint_as_float(raw.z << 16); bb[1] = __uint_as_float(raw.z & 0xffff0000u); bb[2] = __uint_as_float(raw.w << 16); bb[3] = __uint_as_float(raw.w & 0xffff0000u);
          a = (a - mean) * rstd * g0 + b0; bb = (bb - mean) * rstd * g1 + b1;
          *(bf16x8*)(V_lds + (q >> 1) * SHM_V + v_st(s & 63, sc)) = pack8(a, bb); } }
    bf16x8 pw[8]; { const float* wrow = sgw + (size_t)(g * 128 + tb * 32 + r32) * 128 + hi * 8;
#pragma unroll
      for (int f = 0; f < 8; ++f) pw[f] = pack8(*(const f32x4*)(wrow + 16 * f), *(const f32x4*)(wrow + 16 * f + 4)); }
    __syncthreads();
    f32x16 o[2] = {}; const int vb0 = (int)(uintptr_t)V_lds + v_rd_base(lane) + dh * 1024;
    pv_half<0>(o, vb0, pw[0], pw[1], pw[2], pw[3]);
    pv_half<1>(o, vb0, pw[4], pw[5], pw[6], pw[7]);
    const int row0 = cb + tb * 32, col0 = g * 128 + dh * 64;
#pragma unroll
    for (int r = 0; r < 16; ++r) { const int t = tb * 32 + crow(r, hi); const float bias = sgb[g * 128 + t];
#pragma unroll
        for (int i = 0; i < 2; ++i) { const size_t row = (size_t)(row0 + crow(r, hi)); const int col = col0 + 32 * i + r32;
            const float v = bf2f(GU[row * 1024 + col]) * (o[i][r] + bias); const float vn = __shfl_xor(v, 1);
            if ((r32 & 1) == 0) *(unsigned*)(AB + row * 2048 + col) = cvtpk(v, vn); } }
    __syncthreads();
}
#undef TRRD
#undef PV_D0
#undef PK4
#undef SBAR
}
DEV void p_mixers(unsigned char* lds, int G, const bf16_t* GU, const bf16_t* GV, const float* stats, const float* ln_g, const float* ln_b, const float* sgw, const float* sgb,
                  const bf16_t* Qg, const bf16_t* Kg, const bf16_t* Vg, const float* sink, bf16_t* AB) {
    for (int u = blockIdx.x; u < NB * 32 * 4; u += G) { const int hp = u & 3, n = (u >> 2) & 31, b = u >> 7; att::attn_unit(lds, Qg, Kg, Vg, sink, AB, b, n, hp); }
    for (int u = blockIdx.x; u < 64 * 8; u += G) att::sg_unit(lds, GU, GV, stats, ln_g, ln_b, sgw, sgb, AB, u >> 3, u & 7);
}

struct Params { const float* in[18]; float* out; unsigned char* ws; };
__global__ void __launch_bounds__(NWAVES * 64, 2) mk_fwd(Params p) {
    extern __shared__ __attribute__((aligned(16))) unsigned char lds[];
    const int G = gridDim.x;
    LAS unsigned char* ldsl = (LAS unsigned char*)lds;
    for (int u = threadIdx.x; u < (LDS_BYTES - LDSCTL_OFF) / 4; u += NWAVES * 64) ((LAS unsigned*)(ldsl + LDSCTL_OFF))[u] = 0u;
    __syncthreads();
    XcdBarrier bar = xcd_barrier_post((unsigned*)(p.ws + WS_CTL) + CW_BAR, (volatile LAS unsigned*)(ldsl + MISC_OFF) + 8);
#define MKCTX() Ctx c; { int t_ = threadIdx.x; asm volatile("" : "+v"(t_)); c.tid = t_; c.lane = t_ & 63; c.wave = __builtin_amdgcn_readfirstlane(t_ >> 6); \
        c.gw = blockIdx.x * NWAVES + c.wave; c.NGW = G * NWAVES; c.gtid = blockIdx.x * (NWAVES * 64) + t_; c.NGT = G * NWAVES * 64; c.lds = lds; }
#define WSP(T, off) ((T*)(p.ws + (off)))
#define x_in p.in[0]
#define norm_mix_pre p.in[1]
#define w_in p.in[2]
#define sg_ln_g p.in[3]
#define sg_ln_b p.in[4]
#define sg_w p.in[5]
#define sg_b p.in[6]
#define attn_sink p.in[7]
#define w_a p.in[8]
#define w_b p.in[9]
#define w_out p.in[10]
#define norm_mix_post p.in[11]
#define norm_ffn_pre p.in[12]
#define w_up p.in[13]
#define conv_w p.in[14]
#define conv_b p.in[15]
#define w_down p.in[16]
#define norm_ffn_post p.in[17]
#define out_f p.out
#define WinT WSP(bf16_t, WS_WIN)
#define WabT WSP(bf16_t, WS_WAB)
#define WoT WSP(bf16_t, WS_WO)
#define WupT WSP(bf16_t, WS_WUP)
#define WdT WSP(bf16_t, WS_WDN)
#define XN WSP(bf16_t, WS_XN)
#define GU WSP(bf16_t, WS_GU)
#define GV WSP(bf16_t, WS_GV)
#define STATS WSP(float, WS_STATS)
#define Q WSP(bf16_t, WS_Q)
#define Kb WSP(bf16_t, WS_K)
#define Vb WSP(bf16_t, WS_V)
#define RA WSP(bf16_t, WS_RA)
#define SB WSP(bf16_t, WS_SB)
#define AB WSP(bf16_t, WS_AB)
#define P1 WSP(float, WS_P1)
#define MG WSP(bf16_t, WS_MG)
#define Y WSP(float, WS_Y)
#define HF WSP(bf16_t, WS_HF)
#define U WSP(bf16_t, WS_U)
#define H WSP(bf16_t, WS_H)
#define F WSP(float, WS_F)
#define cosT WSP(float, WS_ROPE)
#define sinT (WSP(float, WS_ROPE) + SEQ * 16)
#define GRID_BAR() xcd_barrier(bar)
#define GEMM(EPI, ...) pg8::gemm_phase<EPI, pg8::StaticOrder, true, true>(ldsl, __VA_ARGS__)
    { MKCTX();
    p_transpose(c, w_in, WinT, DM, INW, INW, DM, 0, 1);
    p_transpose(c, w_a, WabT, 1024, DM, DM, 2048, 0, 0);
    p_transpose(c, w_b, WabT, 1024, DM, DM, 2048, 1024, 0);
    p_transpose(c, w_out, WoT, DM, DM, DM, DM, 0, 0);
    p_transpose(c, w_up, WupT, DM, UPW, UPW, DM, 0, 2);
    p_transpose(c, w_down, WdT, DFF, DM, DM, DFF, 0, 0);
    p_rms_in(c, x_in, norm_mix_pre, XN);
    p_rope_table(c, cosT, sinT);
    for (int i = c.gtid; i < MTOK * 2; i += c.NGT) STATS[i] = 0.f; }
    GRID_BAR();
    { pg8::Gemm g{XN, WinT, MTOK, INW, DM, DM, DM, 0}; pg8::StaticOrder S; S.init(g.M, g.N, G, (int)blockIdx.x);
      pg8::EpiIn E{GU, GV, Q, Kb, Vb, RA, SB, STATS, cosT, sinT}; GEMM(pg8::EpiIn, g, S, E); }
    GRID_BAR();
    p_mixers(lds, G, GU, GV, STATS, sg_ln_g, sg_ln_b, sg_w, sg_b, Q, Kb, Vb, attn_sink, AB);
    GRID_BAR();
    { pg8::Gemm g{AB, WabT, MTOK, DM, 1024, 2048, 2048, 0}; pg8::StaticOrder S; S.init(g.M, g.N, G, (int)blockIdx.x); pg8::EpiF32 E{P1, RA, DM, DM}; GEMM(pg8::EpiF32, g, S, E); }
    GRID_BAR();
    { pg8::Gemm g{AB + 1024, WabT + 1024, MTOK, DM, 1024, 2048, 2048, 0}; pg8::StaticOrder S; S.init(g.M, g.N, G, (int)blockIdx.x); pg8::EpiMerge E{MG, P1, SB, DM, 0}; GEMM(pg8::EpiMerge, g, S, E); }
    GRID_BAR();
    { pg8::Gemm g{MG, WoT, MTOK, DM, DM, DM, DM, 0}; pg8::StaticOrder S; S.init(g.M, g.N, G, (int)blockIdx.x); pg8::EpiF32 E{Y, nullptr, DM, 0}; GEMM(pg8::EpiF32, g, S, E); }
    GRID_BAR();
    { MKCTX(); p_post4(c, Y, x_in, norm_mix_post, norm_ffn_pre, out_f, HF); }
    GRID_BAR();
    { pg8::Gemm g{HF - DM, WupT, 33 * 256, UPW, DM, DM, DM, 0}; pg8::StaticOrder S; S.init(g.M, g.N, G, (int)blockIdx.x);
      pg8::EpiConvGlu E{H, conv_w, conv_b}; GEMM(pg8::EpiConvGlu, g, S, E); }
    GRID_BAR();
    { pg8::Gemm g{H, WdT, MTOK, DM, DFF, DFF, DFF, 0}; pg8::StaticOrder S; S.init(g.M, g.N, G, (int)blockIdx.x); pg8::EpiF32 E{F, nullptr, DM, 0}; GEMM(pg8::EpiF32, g, S, E); }
    GRID_BAR();
    { MKCTX(); p_post6(c, F, norm_ffn_post, out_f); }
#undef x_in
#undef out_f
#undef Q
#undef U
#undef H
#undef F
#undef Y
}

extern "C" void kernel_launch(void* const* d_in, const int* in_sizes, int n_in, void* d_out, int out_size, void* d_ws, size_t ws_size, hipStream_t stream) {
    (void)in_sizes; (void)out_size;
    static int grid = 0;
    if (grid == 0) {
        if (n_in != 18 || ws_size < WS_END) { fprintf(stderr, "kernel_launch: bad inputs / workspace (%d, %zu)\n", n_in, ws_size); grid = -1; return; }
        int dev = 0, cus = 0, per_cu = 0;
        if (hipGetDevice(&dev) != hipSuccess || hipDeviceGetAttribute(&cus, hipDeviceAttributeMultiprocessorCount, dev) != hipSuccess) { grid = -1; return; }
        if (hipFuncSetAttribute((const void*)mk_fwd, hipFuncAttributeMaxDynamicSharedMemorySize, LDS_BYTES) != hipSuccess) { fprintf(stderr, "kernel_launch: hipFuncSetAttribute failed\n"); grid = -1; return; }
        if (hipOccupancyMaxActiveBlocksPerMultiprocessor(&per_cu, (const void*)mk_fwd, NWAVES * 64, LDS_BYTES) != hipSuccess || per_cu < 1) { fprintf(stderr, "kernel_launch: occupancy query says %d blocks/CU\n", per_cu); (void)hipGetLastError(); }
        grid = cus;
    }
    if (grid < 0) return;
    (void)hipMemsetAsync((char*)d_ws + WS_CTL, 0, CTL_ZERO_BYTES, stream);
    Params p{}; for (int i = 0; i < 18; ++i) p.in[i] = (const float*)d_in[i]; p.out = (float*)d_out; p.ws = (unsigned char*)d_ws;
    hipLaunchKernelGGL(mk_fwd, dim3(grid), dim3(NWAVES * 64), LDS_BYTES, stream, p);
}
```
